# Optimizing an MI355X kernel written in HIP

```python
import math
import jax, jax.numpy as jnp
from jax import lax
import numpy as np

D_MODEL = 1024
BATCH = 4
SEQ = 4096
DEPTH = 4

CHUNK = 64
N_META = 16
SB_BLOCK = 128
HEAD_DIM = 64
SB_HEADS = D_MODEL // 128
RW_HEADS = D_MODEL // 128
C_SB = SB_HEADS * HEAD_DIM
C_RW = RW_HEADS * HEAD_DIM
W_LORA = 64
A_LORA = 64
V_LORA = 32
G_LORA = 160
RW_COLS = 3 * C_RW + W_LORA + A_LORA + G_LORA
IN_COLS = 3 * C_SB + RW_COLS + 2 * D_MODEL
FFN_HIDDEN = ((8 * D_MODEL // 3 + 255) // 256) * 256
RMS_EPS = 1e-6
GN_EPS = 64e-5

kernel_name = "hybrid_stickbreaking_rwkv7_gated_trunk"


def rms_norm(x, g):
    xf = x.astype(jnp.float32)
    y = xf * lax.rsqrt(jnp.mean(xf * xf, axis=-1, keepdims=True) + RMS_EPS)
    return (y * g.astype(jnp.float32)).astype(x.dtype)


def split_heads(t, n_heads):
    b, l, _ = t.shape
    return t.reshape(b, l, n_heads, HEAD_DIM)


def token_shift(p, mu):
    prev = jnp.pad(p, ((0, 0), (1, 0), (0, 0)))[:, :-1]
    return p + (prev - p) * mu


def stick_breaking_attention(q, k, v):
    b, l, h, dh = q.shape
    n_blocks = l // SB_BLOCK
    q_blocks = q.reshape(b, n_blocks, SB_BLOCK, h, dh).transpose(1, 0, 2, 3, 4)
    k_pos = jnp.arange(l)
    scale = dh ** -0.5

    def one_block(args):
        i, q_blk = args
        z = jnp.einsum("bqhd,bkhd->bhqk", q_blk, k).astype(jnp.float32) * scale
        q_pos = i * SB_BLOCK + jnp.arange(SB_BLOCK)
        mask = k_pos[None, :] < q_pos[:, None]
        neg_log_one_minus_beta = jnp.where(mask, jax.nn.softplus(z), 0.0)
        between = lax.cumsum(neg_log_one_minus_beta, axis=3, reverse=True) - neg_log_one_minus_beta
        log_a = jax.nn.log_sigmoid(z) - between
        a = jnp.where(mask, jnp.exp(log_a), 0.0)
        return jnp.einsum("bhqk,bkhd->bqhd", a.astype(v.dtype), v)

    out = lax.map(one_block, (jnp.arange(n_blocks), q_blocks))
    return out.transpose(1, 0, 2, 3, 4).reshape(b, l, h, dh)


def rwkv7_recurrence(r, decay, k, v, kk, a):
    b, l, h, n = r.shape
    f32 = jnp.float32

    def step(s, inp):
        r_t, w_t, k_t, v_t, kk_t, a_t = inp
        s_kk = jnp.einsum("bhvk,bhk->bhv", s, -kk_t)
        s = (s * w_t[:, :, None, :]
             + s_kk[..., None] * (kk_t * a_t)[:, :, None, :]
             + v_t[..., None] * k_t[:, :, None, :])
        y = jnp.einsum("bhvk,bhk->bhv", s, r_t)
        return s, y

    xs = tuple(jnp.moveaxis(t.astype(f32), 1, 0) for t in (r, decay, k, v, kk, a))
    s0 = jnp.zeros((b, h, n, n), f32)
    _, ys = lax.scan(step, s0, xs)
    return jnp.moveaxis(ys, 0, 1)


def group_norm_heads(y, w, b):
    mean = jnp.mean(y, axis=-1, keepdims=True)
    var = jnp.mean(jnp.square(y - mean), axis=-1, keepdims=True)
    yn = (y - mean) * lax.rsqrt(var + GN_EPS)
    bb, l, h, n = y.shape
    return yn.reshape(bb, l, h * n) * w.astype(jnp.float32) + b.astype(jnp.float32)


def setup_inputs(seed: int = 0) -> dict:
    key = jax.random.key(seed)
    ks = jax.random.split(key, 32)
    f32 = jnp.float32
    n_vres = DEPTH - 1

    def nrm(k, shape, scale):
        return jax.random.normal(k, shape, f32) * scale

    def gain(k, shape):
        return 1.0 + 0.05 * jax.random.normal(k, shape, f32)

    return {
        "x": nrm(ks[0], (BATCH, SEQ, D_MODEL), 1.0),
        "meta_tokens": nrm(ks[1], (N_META, D_MODEL), 1.0),
        "norm_mix": gain(ks[2], (DEPTH, D_MODEL)),
        "norm_ffn": gain(ks[3], (DEPTH, D_MODEL)),
        "norm_final": gain(ks[4], (D_MODEL,)),
        "w_in": nrm(ks[5], (DEPTH, D_MODEL, IN_COLS), D_MODEL ** -0.5),
        "mu_rw": jax.random.uniform(ks[6], (DEPTH, RW_COLS), f32, 0.2, 0.8),
        "w0": jax.random.uniform(ks[7], (DEPTH, C_RW), f32, -6.5, -1.5),
        "w_up": nrm(ks[8], (DEPTH, W_LORA, C_RW), W_LORA ** -0.5),
        "a0": nrm(ks[9], (DEPTH, C_RW), 0.1),
        "a_up": nrm(ks[10], (DEPTH, A_LORA, C_RW), A_LORA ** -0.5),
        "g_up": nrm(ks[11], (DEPTH, G_LORA, C_RW), G_LORA ** -0.5),
        "k_k": 0.85 + 0.05 * jax.random.normal(ks[12], (DEPTH, C_RW), f32),
        "k_a": gain(ks[13], (DEPTH, C_RW)),
        "r_k": nrm(ks[14], (DEPTH, RW_HEADS, HEAD_DIM), 0.1),
        "ln_x_w": gain(ks[15], (DEPTH, C_RW)),
        "ln_x_b": nrm(ks[16], (DEPTH, C_RW), 0.02),
        "vres_down": nrm(ks[17], (n_vres, D_MODEL, V_LORA), D_MODEL ** -0.5),
        "vres_mu": jax.random.uniform(ks[18], (n_vres, V_LORA), f32, 0.2, 0.8),
        "vres_up": nrm(ks[19], (n_vres, V_LORA, C_RW), V_LORA ** -0.5),
        "vres0": gain(ks[20], (n_vres, C_RW)),
        "w_sb_out": nrm(ks[21], (DEPTH, C_SB, D_MODEL), C_SB ** -0.5),
        "w_rw_out": nrm(ks[22], (DEPTH, C_RW, D_MODEL), C_RW ** -0.5),
        "w_out": nrm(ks[23], (DEPTH, D_MODEL, D_MODEL), D_MODEL ** -0.5),
        "w_ffn_in": nrm(ks[24], (DEPTH, D_MODEL, 2 * FFN_HIDDEN), D_MODEL ** -0.5),
        "w_ffn_out": nrm(ks[25], (DEPTH, FFN_HIDDEN, D_MODEL), FFN_HIDDEN ** -0.5),
    }


def reference(x, meta_tokens, norm_mix, norm_ffn, norm_final, w_in, mu_rw, w0, w_up, a0, a_up,
              g_up, k_k, k_a, r_k, ln_x_w, ln_x_b, vres_down, vres_mu, vres_up, vres0,
              w_sb_out, w_rw_out, w_out, w_ffn_in, w_ffn_out):
    b, s, d = x.shape
    l_real = N_META + s
    l_pad = -(-l_real // SB_BLOCK) * SB_BLOCK
    meta = jnp.broadcast_to(meta_tokens.astype(x.dtype)[None], (b, N_META, d))
    h = jnp.concatenate([meta, x], axis=1)
    h = jnp.pad(h, ((0, 0), (0, l_pad - l_real), (0, 0)))

    in_splits = [C_SB, 2 * C_SB, 3 * C_SB, 3 * C_SB + RW_COLS, 3 * C_SB + RW_COLS + D_MODEL]
    rw_splits = [C_RW, 2 * C_RW, 3 * C_RW, 3 * C_RW + W_LORA, 3 * C_RW + W_LORA + A_LORA]
    v_first = None
    for layer in range(DEPTH):
        xn = rms_norm(h, norm_mix[layer])
        proj = xn @ w_in[layer]
        q_sb, k_sb, v_sb, rw, gate_sb, gate_rw = jnp.split(proj, in_splits, axis=-1)

        y_sb = stick_breaking_attention(split_heads(q_sb, SB_HEADS), split_heads(k_sb, SB_HEADS),
                                        split_heads(v_sb, SB_HEADS)).reshape(b, l_pad, C_SB)

        rw = token_shift(rw, mu_rw[layer])
        r, kr, vr, w_lo, a_lo, g_lo = jnp.split(rw, rw_splits, axis=-1)
        w_log = -jax.nn.softplus(-(w0[layer] + jnp.tanh(w_lo) @ w_up[layer])) - 0.5
        decay = jnp.exp(-jnp.exp(w_log.astype(jnp.float32)))
        a = jax.nn.sigmoid(a0[layer] + a_lo @ a_up[layer])
        g = jax.nn.sigmoid(g_lo) @ g_up[layer]
        if layer == 0:
            v_first = vr
        else:
            v_lo = token_shift(xn @ vres_down[layer - 1], vres_mu[layer - 1])
            vr = vr + (v_first - vr) * jax.nn.sigmoid(vres0[layer - 1] + v_lo @ vres_up[layer - 1])
        kk = split_heads((kr * k_k[layer]).astype(jnp.float32), RW_HEADS)
        kk = kk / jnp.maximum(jnp.linalg.norm(kk, axis=-1, keepdims=True), 1e-12)
        kr = kr * (1.0 + (a - 1.0) * k_a[layer])
        r_h, k_h, v_h, a_h = (split_heads(t, RW_HEADS) for t in (r, kr, vr, a))
        y_rw = rwkv7_recurrence(r_h, split_heads(decay, RW_HEADS), k_h, v_h, kk, a_h)
        y_rw = group_norm_heads(y_rw, ln_x_w[layer], ln_x_b[layer])
        bonus = jnp.sum(r_h * k_h * r_k[layer], axis=-1, keepdims=True) * v_h
        y_rw = ((y_rw + bonus.reshape(b, l_pad, C_RW).astype(jnp.float32)).astype(h.dtype)) * g

        merged = (jax.nn.sigmoid(gate_sb) * (y_sb @ w_sb_out[layer])
                  + jax.nn.sigmoid(gate_rw) * (y_rw @ w_rw_out[layer]))
        h = h + merged @ w_out[layer]

        hn = rms_norm(h, norm_ffn[layer])
        gate_ffn, up_ffn = jnp.split(hn @ w_ffn_in[layer], [FFN_HIDDEN], axis=-1)
        h = h + (jax.nn.silu(gate_ffn) * up_ffn) @ w_ffn_out[layer]

    h = rms_norm(h, norm_final)
    return h[:, N_META:N_META + s]
```

```cpp
#include <hip/hip_runtime.h>
#include <hip/hip_cooperative_groups.h>
#include <cstdio>
#include <cstdint>
namespace cg = cooperative_groups;
#ifndef PROBE_RW2
#define PROBE_RW2 0
#endif
#ifndef PROBE_SYNC2
#define PROBE_SYNC2 0
#endif
#ifndef PROBE_GEMM2
#define PROBE_GEMM2 0
#endif
#ifndef PROBE_MISC2
#define PROBE_MISC2 0
#endif
#ifndef PROBE_SB2
#define PROBE_SB2 0
#endif
#ifndef PROBE_CV2
#define PROBE_CV2 0
#endif
namespace pg8 {
#define PG8_LAS __attribute__((address_space(3)))
typedef unsigned short bf16_t;
typedef short bf16x8 __attribute__((ext_vector_type(8)));
typedef float f32x4 __attribute__((ext_vector_type(4)));
typedef unsigned u32x4 __attribute__((ext_vector_type(4)));
constexpr int BM = 256, BK = 64, HALF = 128, HTB = HALF * BK * 2  , STAGE_BYTES = 8 * HTB, NXCD = 8, WGM = 8;

__host__ __device__ __forceinline__ int lds_byte(int r, int c) { const int st = (r >> 4) * 2 + (c >> 5), rr = r & 15, cc = c & 31, ob = rr * 64 + cc * 2; return st * 1024 + (ob ^ (((ob >> 9) & 1) << 5)); }
__host__ __device__ __forceinline__ void stage_rc(int b, int& R, int& C) { const int st = b / 1024, sb = b % 1024, swz = sb ^ (((sb >> 9) & 1) << 5); R = (st >> 1) * 16 + swz / 64; C = (st & 1) * 32 + (swz % 64) / 2; }
__host__ __device__ __forceinline__ int perm32(int rho) { const int n = rho >> 4, i = rho & 15; return 8 * (i >> 2) + 4 * n + (i & 3); }

struct Unit { int pm, pn; };
struct Gemm { const bf16_t* A; const bf16_t* Bt; int M, N, K; };

struct StaticOrder {
    int nM, nN, nwg, G, c;
    __host__ __device__ void init(int M, int N, int G_, int c_) { nM = M / BM; nN = N / BM; nwg = nM * nN; G = G_; c = c_; }
    __host__ __device__ bool next(int i, Unit& u) const {
        const long L = (long)i * G + c; if (L >= nwg) return false;
        int wgid = (int)L; { const int q = nwg / NXCD, r = nwg % NXCD, xcd = wgid % NXCD, off = wgid / NXCD; wgid = (xcd < r ? xcd * (q + 1) : r * (q + 1) + (xcd - r) * q) + off; }
        const int nig = WGM * nN, gid = wgid / nig, fm = gid * WGM, gsz = (nM - fm) < WGM ? (nM - fm) : WGM;
        u.pm = fm + ((wgid % nig) % gsz); u.pn = (wgid % nig) / gsz; return true;
    }
    __device__ __forceinline__ void a_ready(const Unit&) const {}
    __device__ __forceinline__ void done(const Unit&) const {}
};

__device__ __forceinline__ unsigned cvt_pk_bf16(float lo, float hi) { unsigned r; asm volatile("v_cvt_pk_bf16_f32 %0, %1, %2" : "=v"(r) : "v"(lo), "v"(hi)); return r; }
template <class Epi, class Sched, bool ALIGN_EPI = false, bool SP2 = false>
__device__ __forceinline__ void gemm_phase(PG8_LAS unsigned char* lds, const Gemm g, const Sched& S, const Epi& E) {
    int tid_ = threadIdx.x; asm volatile("" : "+v"(tid_)); const int tid = tid_, wid = __builtin_amdgcn_readfirstlane(tid >> 6), lane = tid & 63, wr = wid >> 2, wc = wid & 3, fr = lane & 15, fq = lane >> 4;
    const int K = g.K, nt = K / BK;
    unsigned voffA[2], voffB[2];
#pragma unroll
    for (int i = 0; i < 2; ++i) { int R, C; stage_rc(tid * 16 + i * 8192, R, C); const int Rb = Epi::PERM ? ((R & ~31) + perm32(R & 31)) : R;
        voffA[i] = (unsigned)(R * K + C) * 2u; voffB[i] = (unsigned)(Rb * K + C) * 2u; }
    const size_t kstep = (size_t)(BK * 2);
    const size_t hstep = (size_t)HALF * K * 2;
    const size_t tstep = 2 * hstep;
    const unsigned ldsw = (unsigned)wid * 1024u;
    const int aoff = lds_byte(wr * 64 + fr, fq * 8), boff = lds_byte(wc * 32 + fr, fq * 8);
#define PG8_SA(b, h) (((b) * 2 + (h)) * HTB)
#define PG8_SB(b, h) ((4 + (b) * 2 + (h)) * HTB)
#define PG8_STAGE(bufoff, gbase, voff) do { _Pragma("unroll") for (int _i = 0; _i < 2; ++_i) \
        __builtin_amdgcn_global_load_lds((const unsigned*)((const char*)(gbase) + (voff)[_i]), (PG8_LAS unsigned*)(lds + (bufoff) + ldsw + _i * 8192), 16, 0, 0); } while (0)
#define PG8_LDA(dst, b, h) do { _Pragma("unroll") for (int m = 0; m < 4; ++m) _Pragma("unroll") for (int k = 0; k < 2; ++k) dst[m][k] = *(const PG8_LAS bf16x8*)(lds + PG8_SA(b, h) + aoff + m * 2048 + k * 1024); } while (0)
#define PG8_LDB(dst, b, h) do { _Pragma("unroll") for (int n = 0; n < 2; ++n) _Pragma("unroll") for (int k = 0; k < 2; ++k) dst[n][k] = *(const PG8_LAS bf16x8*)(lds + PG8_SB(b, h) + boff + n * 2048 + k * 1024); } while (0)
#define PG8_MMA(ai, bj, At, Bt) do { __builtin_amdgcn_s_setprio(1); _Pragma("unroll") for (int m = 0; m < 4; ++m) _Pragma("unroll") for (int n = 0; n < 2; ++n) _Pragma("unroll") for (int k = 0; k < 2; ++k) \
        acc[ai][bj][m][n] = __builtin_amdgcn_mfma_f32_16x16x32_bf16(Bt[n][k], At[m][k], acc[ai][bj][m][n], 0, 0, 0); __builtin_amdgcn_s_setprio(0); } while (0)
#define PG8_WAIT_V(n) asm volatile("s_waitcnt vmcnt(" #n ")" ::: "memory")
#define PG8_WAIT_L(n) asm volatile("s_waitcnt lgkmcnt(" #n ")" ::: "memory")
#define PG8_BAR __builtin_amdgcn_s_barrier()
#define PG8_SCHED __builtin_amdgcn_sched_barrier(0)
    Unit cur, nxt; int ui = 0;
    if (!S.next(0, cur)) return;
    f32x4 acc[2][2][4][2];
#pragma unroll
    for (int a = 0; a < 2; ++a)
#pragma unroll
        for (int b = 0; b < 2; ++b)
#pragma unroll
            for (int m = 0; m < 4; ++m)
#pragma unroll
                for (int n = 0; n < 2; ++n) acc[a][b][m][n] = (f32x4){0.f, 0.f, 0.f, 0.f};
    bf16x8 At[4][2], B0[2][2], B1[2][2];
    const char* cA = (const char*)g.A + (size_t)cur.pm * tstep; const char* cB = (const char*)g.Bt + (size_t)cur.pn * tstep;
    S.a_ready(cur);
    if constexpr (SP2) {
        PG8_STAGE(PG8_SB(0, 0), cB, voffB); PG8_STAGE(PG8_SB(0, 1), cB + hstep, voffB); PG8_STAGE(PG8_SA(0, 0), cA, voffA); PG8_STAGE(PG8_SA(0, 1), cA + hstep, voffA);
        if (wr == 1) PG8_BAR;
        PG8_WAIT_V(2); PG8_BAR;
        PG8_STAGE(PG8_SB(1, 0), cB + kstep, voffB); PG8_STAGE(PG8_SA(1, 0), cA + kstep, voffA); PG8_STAGE(PG8_SB(1, 1), cB + hstep + kstep, voffB);
        PG8_WAIT_V(6); PG8_BAR;
    } else {
        PG8_STAGE(PG8_SB(0, 0), cB, voffB); PG8_STAGE(PG8_SA(0, 0), cA, voffA); PG8_STAGE(PG8_SB(0, 1), cB + hstep, voffB); PG8_STAGE(PG8_SA(0, 1), cA + hstep, voffA);
        if (wr == 1) PG8_BAR;
        PG8_WAIT_V(4); PG8_BAR;
        PG8_STAGE(PG8_SB(1, 0), cB + kstep, voffB); PG8_STAGE(PG8_SA(1, 0), cA + kstep, voffA); PG8_STAGE(PG8_SB(1, 1), cB + hstep + kstep, voffB);
        PG8_WAIT_V(6); PG8_BAR;
    }
    for (;;) {
        const bool has_next = S.next(ui + 1, nxt);
        const char* nA = has_next ? (const char*)g.A + (size_t)nxt.pm * tstep : cA; const char* nB = has_next ? (const char*)g.Bt + (size_t)nxt.pn * tstep : cB;
        for (int t = 0; t < nt; t += 2) {
            const bool last = (t == nt - 2);
            const char* a1 = cA + (size_t)(t + 1) * kstep;
            const char* a2 = last ? nA : cA + (size_t)(t + 2) * kstep; const char* b2 = last ? nB : cB + (size_t)(t + 2) * kstep;
            const char* a3 = a2 + kstep; const char* b3 = b2 + kstep;
            if (last && has_next) S.a_ready(nxt);
            if constexpr (SP2) {
            PG8_LDB(B0, 0, 0); PG8_LDB(B1, 0, 1); PG8_SCHED; PG8_LDA(At, 0, 0); PG8_STAGE(PG8_SA(1, 1), a1 + hstep, voffA);
            PG8_WAIT_V(8); PG8_WAIT_L(0); PG8_BAR; PG8_MMA(0, 0, At, B0); PG8_MMA(0, 1, At, B1); PG8_BAR; PG8_SCHED;
            PG8_LDA(At, 0, 1); PG8_STAGE(PG8_SB(0, 0), b2, voffB); PG8_STAGE(PG8_SB(0, 1), b2 + hstep, voffB); PG8_STAGE(PG8_SA(0, 0), a2, voffA);
            PG8_WAIT_V(8); PG8_WAIT_L(0); PG8_BAR; PG8_MMA(1, 0, At, B0); PG8_MMA(1, 1, At, B1); PG8_BAR; PG8_SCHED;
            PG8_LDB(B0, 1, 0); PG8_LDB(B1, 1, 1); PG8_SCHED; PG8_LDA(At, 1, 0); PG8_STAGE(PG8_SA(0, 1), a2 + hstep, voffA);
            PG8_WAIT_V(8); PG8_WAIT_L(0); PG8_BAR; PG8_MMA(0, 0, At, B0); PG8_MMA(0, 1, At, B1); PG8_BAR; PG8_SCHED;
            PG8_LDA(At, 1, 1); PG8_STAGE(PG8_SB(1, 0), b3, voffB); PG8_STAGE(PG8_SB(1, 1), b3 + hstep, voffB); PG8_STAGE(PG8_SA(1, 0), a3, voffA);
            PG8_WAIT_V(8); PG8_WAIT_L(0); PG8_BAR; PG8_MMA(1, 0, At, B0); PG8_MMA(1, 1, At, B1); PG8_BAR; PG8_SCHED;
            } else {
            PG8_LDB(B0, 0, 0); PG8_SCHED; PG8_LDA(At, 0, 0); PG8_STAGE(PG8_SA(1, 1), a1 + hstep, voffA);
            PG8_WAIT_L(8); PG8_BAR; PG8_WAIT_L(0); PG8_MMA(0, 0, At, B0); PG8_BAR; PG8_SCHED;
            PG8_LDB(B1, 0, 1); PG8_STAGE(PG8_SB(0, 0), b2, voffB);
            PG8_BAR; PG8_WAIT_L(0); PG8_MMA(0, 1, At, B1); PG8_BAR;
            PG8_LDA(At, 0, 1); PG8_STAGE(PG8_SA(0, 0), a2, voffA);
            PG8_BAR; PG8_WAIT_L(0); PG8_MMA(1, 0, At, B0); PG8_BAR; PG8_SCHED;
            PG8_STAGE(PG8_SB(0, 1), b2 + hstep, voffB);
            PG8_WAIT_V(6); PG8_BAR; PG8_MMA(1, 1, At, B1); PG8_BAR;
            PG8_LDB(B0, 1, 0); PG8_SCHED; PG8_LDA(At, 1, 0); PG8_STAGE(PG8_SA(0, 1), a2 + hstep, voffA);
            PG8_WAIT_L(8); PG8_BAR; PG8_WAIT_L(0); PG8_MMA(0, 0, At, B0); PG8_BAR; PG8_SCHED;
            PG8_LDB(B1, 1, 1); PG8_STAGE(PG8_SB(1, 0), b3, voffB);
            PG8_BAR; PG8_WAIT_L(0); PG8_MMA(0, 1, At, B1); PG8_BAR;
            PG8_LDA(At, 1, 1); PG8_STAGE(PG8_SA(1, 0), a3, voffA);
            PG8_BAR; PG8_WAIT_L(0); PG8_MMA(1, 0, At, B0); PG8_BAR; PG8_SCHED;
            PG8_STAGE(PG8_SB(1, 1), b3 + hstep, voffB);
            PG8_WAIT_V(6); PG8_BAR; PG8_MMA(1, 1, At, B1); PG8_BAR;
            }
        }
        if constexpr (ALIGN_EPI) { if (wr == 0) PG8_BAR; }
        if constexpr (!Epi::AFTER_DRAIN) { E(acc, cur, wr, wc, fr, fq); S.done(cur); }
        if (!has_next) break;
#pragma unroll
        for (int a = 0; a < 2; ++a)
#pragma unroll
            for (int b = 0; b < 2; ++b)
#pragma unroll
                for (int m = 0; m < 4; ++m)
#pragma unroll
                    for (int n = 0; n < 2; ++n) acc[a][b][m][n] = (f32x4){0.f, 0.f, 0.f, 0.f};
        cur = nxt; cA = nA; cB = nB; ++ui;
        if constexpr (ALIGN_EPI) { if (wr == 1) PG8_BAR; }
    }
    PG8_WAIT_V(0);
    if constexpr (!ALIGN_EPI) { if (wr == 0) PG8_BAR; }
    PG8_BAR;
    if constexpr (Epi::AFTER_DRAIN) { E.fused(acc, cur, wr, wc, fr, fq, lds, wid, lane); S.done(cur); }
#undef PG8_SA
#undef PG8_SB
#undef PG8_STAGE
#undef PG8_LDA
#undef PG8_LDB
#undef PG8_MMA
#undef PG8_WAIT_V
#undef PG8_WAIT_L
#undef PG8_BAR
#undef PG8_SCHED
}
}
constexpr int DM = 1024, NB = 4, SEQ = 4096, NMETA = 16, LT = SEQ + NMETA  , T = NB * LT  , MP = 16640  , DEPTH = 4;
constexpr int RWCOLS = 1824, INCOLS = 5408, FFH = 2816, NH = 8;
constexpr float RMS_EPS = 1e-6f, GN_EPS = 64e-5f;
constexpr float C2 = 0.125f * 1.4426950408889634f;
constexpr int NWAVES = 8, NTHREADS = 512;

#define LAS __attribute__((address_space(3)))
typedef unsigned short bf16_t;
typedef short bf16x8 __attribute__((ext_vector_type(8)));
typedef short s16x4 __attribute__((ext_vector_type(4)));
typedef float f32x4 __attribute__((ext_vector_type(4)));
typedef float f32x16 __attribute__((ext_vector_type(16)));
typedef unsigned u32x4 __attribute__((ext_vector_type(4)));
typedef unsigned u32x2 __attribute__((ext_vector_type(2)));
typedef float f32x2_t __attribute__((ext_vector_type(2))); typedef __bf16 bf16x2_t __attribute__((ext_vector_type(2)));
__device__ __forceinline__ unsigned cvt_pk_bf16(float lo, float hi) { f32x2_t v = {lo, hi}; bf16x2_t b = __builtin_convertvector(v, bf16x2_t); return __builtin_bit_cast(unsigned, b); }

constexpr size_t al256(size_t x) { return (x + 255) & ~(size_t)255; }
constexpr size_t OFF_SSQ = 0;
constexpr size_t OFF_BONUS = al256(OFF_SSQ + (size_t)2 * MP * 16 * 4);
constexpr size_t OFF_W1A = al256(OFF_BONUS + (size_t)T * 8 * 4);
constexpr size_t OFF_WV = OFF_W1A + (size_t)3072 * 1024 * 2;
constexpr size_t OFF_WG = OFF_WV + (size_t)512 * 1024 * 2;
constexpr size_t OFF_WL = OFF_WG + (size_t)2048 * 1024 * 2;
constexpr size_t OFF_WSB = OFF_WL + (size_t)2048 * 384 * 2;
constexpr size_t OFF_WRW = OFF_WSB + (size_t)1024 * 512 * 2;
constexpr size_t OFF_WO = OFF_WRW + (size_t)1024 * 512 * 2;
constexpr size_t OFF_H = OFF_WO + (size_t)1024 * 1024 * 2;
constexpr size_t OFF_HB = OFF_H + (size_t)MP * 1024 * 4;
constexpr size_t OFF_VFIRST = OFF_HB + (size_t)MP * 1024 * 2;
constexpr size_t OFF_E = al256(OFF_VFIRST + (size_t)T * 512 * 2);
constexpr size_t OFF_F = OFF_E + (size_t)MP * 2048 * 2;
constexpr size_t OFF_G = OFF_F + (size_t)MP * 2048 * 2;
constexpr size_t OFF_WF1 = OFF_H;
constexpr size_t OFF_WF2 = OFF_WF1 + (size_t)5632 * 1024 * 2;
constexpr size_t OFF_HH = OFF_G + (size_t)MP * 1024 * 2;
constexpr size_t OFF_I = OFF_HH + (size_t)512 * MP * 2;
constexpr size_t OFF_J = OFF_I + (size_t)MP * 512 * 2;
constexpr size_t OFF_BAR = al256(OFF_J + (size_t)MP * 512 * 2);
constexpr size_t WS_END = OFF_BAR + 16384;
static_assert(WS_END <= (size_t)369098752, "workspace map exceeds 4x the largest input tensor");
static_assert((size_t)MP * 2816 * 2 <= 2 * (size_t)MP * 2048 * 2, "HID fits E+F");

constexpr int LDS_BYTES = 147456;

__device__ __forceinline__ float bf2f(bf16_t v) { return __uint_as_float((unsigned)v << 16); }
__device__ __forceinline__ float bflo(unsigned w) { return __uint_as_float(w << 16); }
__device__ __forceinline__ float bfhi(unsigned w) { return __uint_as_float(w & 0xffff0000u); }
__device__ __forceinline__ bf16_t f2bf(float f) { return (bf16_t)(cvt_pk_bf16(f, 0.f) & 0xffffu); }
__device__ __forceinline__ int opq(int v) { asm volatile("" : "+v"(v)); return v; }
template <int CTRL, int ROWMASK> __device__ __forceinline__ float dpp0(float v) { return __builtin_bit_cast(float, __builtin_amdgcn_update_dpp(0, __builtin_bit_cast(int, v), CTRL, ROWMASK, 0xF, false)); }
__device__ __forceinline__ float wave_sum(float v) {
    v += dpp0<0xB1, 0xF>(v);
    v += dpp0<0x4E, 0xF>(v);
    v += dpp0<0x141, 0xF>(v);
    v += dpp0<0x140, 0xF>(v);
    v += dpp0<0x142, 0xA>(v);
    v += dpp0<0x143, 0xC>(v);
    return __builtin_bit_cast(float, __builtin_amdgcn_readlane(__builtin_bit_cast(int, v), 63));
}
__device__ __forceinline__ float row_rstd(const float* part, int row) {
    const f32x4* p = (const f32x4*)(part + (size_t)row * 16);
    const f32x4 a = p[0], b = p[1], c = p[2], d = p[3];
    const float s = ((a[0] + a[1]) + (a[2] + a[3])) + ((b[0] + b[1]) + (b[2] + b[3])) + (((c[0] + c[1]) + (c[2] + c[3])) + ((d[0] + d[1]) + (d[2] + d[3])));
    return rsqrtf(s * (1.f / 1024.f) + RMS_EPS);
}
__device__ __forceinline__ float fexp(float x) { return __builtin_amdgcn_exp2f(1.4426950408889634f * x); }
__device__ __forceinline__ float fsigmoid(float x) { return __builtin_amdgcn_rcpf(1.f + __builtin_amdgcn_exp2f(-1.4426950408889634f * x)); }
__device__ __forceinline__ float fsoftplus(float x) { return fmaxf(x, 0.f) + 0.6931471805599453f * __builtin_amdgcn_logf(1.f + __builtin_amdgcn_exp2f(-1.4426950408889634f * fabsf(x))); }

template <int ACT, bool HAS_SSQ> struct EpiStore {
    static constexpr bool PERM = true, AFTER_DRAIN = false;
    bf16_t* O0; int ld0; bf16_t* O1; int ld1; int split; const float* ssq; float scale0; int n0;
    __device__ __forceinline__ void operator()(const f32x4 (&acc)[2][2][4][2], const pg8::Unit& u, int wr, int wc, int fr, int fq) const {
        bf16_t* base; int ld, colt;
        if (u.pn < split) { base = O0; ld = ld0; colt = u.pn * 256; } else { base = O1; ld = ld1; colt = (u.pn - split) * 256; }
        const float sc = (u.pn < n0) ? scale0 : 1.f;
        const int row0 = u.pm * 256 + wr * 64 + fr;
        unsigned off = (unsigned)row0 * (unsigned)ld + (unsigned)(colt + wc * 32 + 8 * fq);
#pragma unroll
        for (int ai = 0; ai < 2; ++ai) {
#pragma unroll
            for (int m = 0; m < 4; ++m) {
                float rs = sc; if (HAS_SSQ) rs *= row_rstd(ssq, row0 + ai * 128 + m * 16);
#pragma unroll
                for (int bj = 0; bj < 2; ++bj) {
                    f32x4 v0 = acc[ai][bj][m][0] * rs, v1 = acc[ai][bj][m][1] * rs;
                    if (ACT) {
#pragma unroll
                        for (int e = 0; e < 4; ++e) { v0[e] = fsigmoid(v0[e]); v1[e] = fsigmoid(v1[e]); }
                    }
                    u32x4 w; w.x = cvt_pk_bf16(v0[0], v0[1]); w.y = cvt_pk_bf16(v0[2], v0[3]); w.z = cvt_pk_bf16(v1[0], v1[1]); w.w = cvt_pk_bf16(v1[2], v1[3]);
                    *(u32x4*)(base + off + bj * 128) = w;
                }
                off += 16u * (unsigned)ld;
                asm volatile("" ::: "memory");
            }
            off += 64u * (unsigned)ld;
        }
    }
};
struct EpiVT {
    static constexpr bool PERM = true, AFTER_DRAIN = false;
    bf16_t* O; int ld; const float* ssq;
    __device__ __forceinline__ void operator()(const f32x4 (&acc)[2][2][4][2], const pg8::Unit& u, int wr, int wc, int fr, int fq) const {
        const int row0 = u.pm * 256 + wr * 64 + fr, col0 = u.pn * 256 + wc * 32 + 8 * fq;
        f32x4 rs[2][2];
#pragma unroll
        for (int bj = 0; bj < 2; ++bj)
#pragma unroll
            for (int n = 0; n < 2; ++n)
#pragma unroll
                for (int e = 0; e < 4; ++e) rs[bj][n][e] = row_rstd(ssq, col0 + bj * 128 + 4 * n + e);
#pragma unroll
        for (int ai = 0; ai < 2; ++ai)
#pragma unroll
            for (int m = 0; m < 4; ++m) {
                bf16_t* rowp = O + (size_t)(row0 + ai * 128 + m * 16) * ld + col0;
#pragma unroll
                for (int bj = 0; bj < 2; ++bj) {
                    const f32x4 v0 = acc[ai][bj][m][0] * rs[bj][0], v1 = acc[ai][bj][m][1] * rs[bj][1];
                    u32x4 w; w.x = cvt_pk_bf16(v0[0], v0[1]); w.y = cvt_pk_bf16(v0[2], v0[3]); w.z = cvt_pk_bf16(v1[0], v1[1]); w.w = cvt_pk_bf16(v1[2], v1[3]);
                    *(u32x4*)(rowp + bj * 128) = w;
                }
            }
    }
};
struct EpiGateMul {
    static constexpr bool PERM = true, AFTER_DRAIN = false;
    bf16_t* O; const bf16_t* gate; int ldg; int gcol; int accum;
    __device__ __forceinline__ void operator()(const f32x4 (&acc)[2][2][4][2], const pg8::Unit& u, int wr, int wc, int fr, int fq) const {
        const int row0 = u.pm * 256 + wr * 64 + fr, col0 = u.pn * 256 + wc * 32 + 8 * fq;
#pragma unroll
        for (int ai = 0; ai < 2; ++ai)
#pragma unroll
            for (int m = 0; m < 4; ++m) {
                const int row = row0 + ai * 128 + m * 16;
#pragma unroll
                for (int bj = 0; bj < 2; ++bj) {
                    const int col = col0 + bj * 128;
                    const u32x4 g = *(const u32x4*)(gate + (size_t)row * ldg + gcol + col);
                    bf16_t* op = O + (size_t)row * 1024 + col;
                    u32x4 p = (u32x4){0u, 0u, 0u, 0u}; if (accum) p = *(const u32x4*)op;
                    const f32x4 a0 = acc[ai][bj][m][0], a1 = acc[ai][bj][m][1];
                    u32x4 w;
                    w.x = cvt_pk_bf16(bflo(g.x) * a0[0] + bflo(p.x), bfhi(g.x) * a0[1] + bfhi(p.x));
                    w.y = cvt_pk_bf16(bflo(g.y) * a0[2] + bflo(p.y), bfhi(g.y) * a0[3] + bfhi(p.y));
                    w.z = cvt_pk_bf16(bflo(g.z) * a1[0] + bflo(p.z), bfhi(g.z) * a1[1] + bfhi(p.z));
                    w.w = cvt_pk_bf16(bflo(g.w) * a1[2] + bflo(p.w), bfhi(g.w) * a1[3] + bfhi(p.w));
                    *(u32x4*)op = w;
                }
            }
    }
};
struct EpiResid {
    static constexpr bool PERM = true, AFTER_DRAIN = false;
    bf16_t* HB; float* ssq_next;
    __device__ __forceinline__ void operator()(const f32x4 (&acc)[2][2][4][2], const pg8::Unit& u, int wr, int wc, int fr, int fq) const {
        const int row0 = u.pm * 256 + wr * 64 + fr, col0 = u.pn * 256 + wc * 32 + 8 * fq;
#pragma unroll
        for (int ai = 0; ai < 2; ++ai)
#pragma unroll
            for (int m = 0; m < 4; ++m) {
                const int row = row0 + ai * 128 + m * 16; float ss = 0.f;
#pragma unroll
                for (int bj = 0; bj < 2; ++bj) {
                    bf16_t* hp = HB + (size_t)row * 1024 + col0 + bj * 128;
                    const u32x4 hb = *(const u32x4*)hp;
                    f32x4 h0 = (f32x4){bflo(hb.x), bfhi(hb.x), bflo(hb.y), bfhi(hb.y)}, h1 = (f32x4){bflo(hb.z), bfhi(hb.z), bflo(hb.w), bfhi(hb.w)};
                    h0 += acc[ai][bj][m][0]; h1 += acc[ai][bj][m][1];
                    u32x4 w; w.x = cvt_pk_bf16(h0[0], h0[1]); w.y = cvt_pk_bf16(h0[2], h0[3]); w.z = cvt_pk_bf16(h1[0], h1[1]); w.w = cvt_pk_bf16(h1[2], h1[3]);
                    *(u32x4*)hp = w;
                    ss += (h0[0] * h0[0] + h0[1] * h0[1]) + (h0[2] * h0[2] + h0[3] * h0[3]) + (h1[0] * h1[0] + h1[1] * h1[1]) + (h1[2] * h1[2] + h1[3] * h1[3]);
                }
                ss += __shfl_xor(ss, 16); ss += __shfl_xor(ss, 32);
                if (fq == 0) ssq_next[(size_t)row * 16 + u.pn * 4 + wc] = ss;
            }
    }
};
struct EpiSwiglu {
    static constexpr bool PERM = true, AFTER_DRAIN = false;
    bf16_t* O; const float* ssq;
    __device__ __forceinline__ void operator()(const f32x4 (&acc)[2][2][4][2], const pg8::Unit& u, int wr, int wc, int fr, int fq) const {
        const int row0 = u.pm * 256 + wr * 64 + fr, hcol0 = u.pn * 128 + wc * 16 + 4 * fq;
#pragma unroll
        for (int ai = 0; ai < 2; ++ai)
#pragma unroll
            for (int m = 0; m < 4; ++m) {
                const int row = row0 + ai * 128 + m * 16;
                const float rs = row_rstd(ssq, row);
#pragma unroll
                for (int bj = 0; bj < 2; ++bj) {
                    const f32x4 g = acc[ai][bj][m][0] * rs, up = acc[ai][bj][m][1] * rs;
                    float hv[4];
#pragma unroll
                    for (int e = 0; e < 4; ++e) hv[e] = g[e] * fsigmoid(g[e]) * up[e];
                    u32x2 w; w.x = cvt_pk_bf16(hv[0], hv[1]); w.y = cvt_pk_bf16(hv[2], hv[3]);
                    *(u32x2*)(O + (size_t)row * FFH + hcol0 + bj * 64) = w;
                }
            }
    }
};


constexpr int MB = 16384;
struct TStoreP { bf16_t* O0; int ld0; bf16_t* O1; int ld1; int split_col; const float* ssq; float scale0; int n0_col; };
template <int ACT, bool HAS_SSQ> struct TStore { TStoreP p;
    __device__ __forceinline__ void operator()(int row, int col0, const float (&v)[8], int) const {
        bf16_t* base; int ld, col;
        if (col0 < p.split_col) { base = p.O0; ld = p.ld0; col = col0; } else { base = p.O1; ld = p.ld1; col = col0 - p.split_col; }
        float rs = (col0 < p.n0_col) ? p.scale0 : 1.f; if (HAS_SSQ) rs *= row_rstd(p.ssq, row);
        float o[8];
#pragma unroll
        for (int e = 0; e < 8; ++e) { o[e] = v[e] * rs; if (ACT) o[e] = fsigmoid(o[e]); }
        u32x4 w; w.x = cvt_pk_bf16(o[0], o[1]); w.y = cvt_pk_bf16(o[2], o[3]); w.z = cvt_pk_bf16(o[4], o[5]); w.w = cvt_pk_bf16(o[6], o[7]);
        *(u32x4*)(base + (size_t)row * ld + col) = w;
    } };
struct TVT { bf16_t* O; int ld; const float* ssq;
    __device__ __forceinline__ void operator()(int row, int col0, const float (&v)[8], int) const {
        const float rs = row_rstd(ssq, row);
#pragma unroll
        for (int e = 0; e < 8; ++e) O[(size_t)(col0 + e) * ld + row] = f2bf(v[e] * rs);
    } };
struct TGateMul { bf16_t* O; const bf16_t* gate; int ldg; int gcol; int accum;
    __device__ __forceinline__ void operator()(int row, int col0, const float (&v)[8], int) const {
        const u32x4 g = *(const u32x4*)(gate + (size_t)row * ldg + gcol + col0); bf16_t* op = O + (size_t)row * 1024 + col0;
        u32x4 p = (u32x4){0u, 0u, 0u, 0u}; if (accum) p = *(const u32x4*)op;
        u32x4 w;
        w.x = cvt_pk_bf16(bflo(g.x) * v[0] + bflo(p.x), bfhi(g.x) * v[1] + bfhi(p.x)); w.y = cvt_pk_bf16(bflo(g.y) * v[2] + bflo(p.y), bfhi(g.y) * v[3] + bfhi(p.y));
        w.z = cvt_pk_bf16(bflo(g.z) * v[4] + bflo(p.z), bfhi(g.z) * v[5] + bfhi(p.z)); w.w = cvt_pk_bf16(bflo(g.w) * v[6] + bflo(p.w), bfhi(g.w) * v[7] + bfhi(p.w));
        *(u32x4*)op = w;
    } };
struct TResid { bf16_t* HB; float* ssq_next;
    __device__ __forceinline__ void operator()(int row, int col0, const float (&v)[8], int unit) const {
        bf16_t* hp = HB + (size_t)row * 1024 + col0; const u32x4 hb = *(const u32x4*)hp;
        f32x4 h0 = (f32x4){bflo(hb.x), bfhi(hb.x), bflo(hb.y), bfhi(hb.y)}, h1 = (f32x4){bflo(hb.z), bfhi(hb.z), bflo(hb.w), bfhi(hb.w)};
        h0 += (f32x4){v[0], v[1], v[2], v[3]}; h1 += (f32x4){v[4], v[5], v[6], v[7]};
        u32x4 w; w.x = cvt_pk_bf16(h0[0], h0[1]); w.y = cvt_pk_bf16(h0[2], h0[3]); w.z = cvt_pk_bf16(h1[0], h1[1]); w.w = cvt_pk_bf16(h1[2], h1[3]);
        *(u32x4*)hp = w;
        float ss = (h0[0] * h0[0] + h0[1] * h0[1]) + (h0[2] * h0[2] + h0[3] * h0[3]) + (h1[0] * h1[0] + h1[1] * h1[1]) + (h1[2] * h1[2] + h1[3] * h1[3]);
        ss += __shfl_xor(ss, 1); ss += __shfl_xor(ss, 2); ss += __shfl_xor(ss, 4);
        if ((col0 & 63) == 0) ssq_next[(size_t)row * 16 + unit] = ss;
    } };
struct TSwiglu { bf16_t* O; const float* ssq;
    __device__ __forceinline__ void operator()(int row, int col0, const float (&v)[8], int) const {
        const float rs = row_rstd(ssq, row); float hv[4];
#pragma unroll
        for (int e = 0; e < 4; ++e) { const float g = v[e] * rs, up = v[4 + e] * rs; hv[e] = g * fsigmoid(g) * up; }
        u32x2 w; w.x = cvt_pk_bf16(hv[0], hv[1]); w.y = cvt_pk_bf16(hv[2], hv[3]);
        *(u32x2*)(O + (size_t)row * FFH + (col0 >> 1)) = w;
    } };
template <class TE> __device__ __forceinline__ void tail_gemm(LAS unsigned char* lds, const bf16_t* A, const bf16_t* Bt, int K, int N, const TE& E, int wave, int lane, int boff = 0) {
    const int r32 = lane & 31, hi = lane >> 5, kw = K >> 3, k0 = wave * kw, tid = opq((int)threadIdx.x);
    if (boff >= (int)gridDim.x) boff = 0;
    LAS float* P = (LAS float*)lds;
    for (int unit = (int)blockIdx.x >= boff ? (int)blockIdx.x - boff : (int)blockIdx.x + (int)gridDim.x - boff; unit < (N >> 6); unit += gridDim.x) {
        f32x16 acc[2][2];
#pragma unroll
        for (int i = 0; i < 2; ++i)
#pragma unroll
            for (int j = 0; j < 2; ++j)
#pragma unroll
                for (int r = 0; r < 16; ++r) acc[i][j][r] = 0.f;
        const bf16_t* ap = A + (size_t)r32 * K + k0 + hi * 8;
        const bf16_t* bp = Bt + (size_t)(unit * 64 + r32) * K + k0 + hi * 8;
#pragma unroll 4
        for (int ks = 0; ks < kw; ks += 16) {
            const bf16x8 a0 = *(const bf16x8*)(ap + ks), a1 = *(const bf16x8*)(ap + (size_t)32 * K + ks), b0 = *(const bf16x8*)(bp + ks), b1 = *(const bf16x8*)(bp + (size_t)32 * K + ks);
            acc[0][0] = __builtin_amdgcn_mfma_f32_32x32x16_bf16(a0, b0, acc[0][0], 0, 0, 0); acc[0][1] = __builtin_amdgcn_mfma_f32_32x32x16_bf16(a0, b1, acc[0][1], 0, 0, 0);
            acc[1][0] = __builtin_amdgcn_mfma_f32_32x32x16_bf16(a1, b0, acc[1][0], 0, 0, 0); acc[1][1] = __builtin_amdgcn_mfma_f32_32x32x16_bf16(a1, b1, acc[1][1], 0, 0, 0);
        }
#pragma unroll
        for (int i = 0; i < 2; ++i)
#pragma unroll
            for (int j = 0; j < 2; ++j)
#pragma unroll
                for (int r = 0; r < 16; ++r) P[(wave * 64 + 32 * i + (r & 3) + 8 * (r >> 2) + 4 * hi) * 64 + 32 * j + r32] = acc[i][j][r];
        __syncthreads();
        const int row = tid >> 3, cgp = tid & 7; float v[8];
#pragma unroll
        for (int e = 0; e < 8; ++e) v[e] = 0.f;
#pragma unroll
        for (int w = 0; w < 8; ++w) { const f32x4 p0 = *(const LAS f32x4*)(P + (w * 64 + row) * 64 + cgp * 8), p1 = *(const LAS f32x4*)(P + (w * 64 + row) * 64 + cgp * 8 + 4);
            v[0] += p0[0]; v[1] += p0[1]; v[2] += p0[2]; v[3] += p0[3]; v[4] += p1[0]; v[5] += p1[1]; v[6] += p1[2]; v[7] += p1[3]; }
        E(MB + row, unit * 64 + cgp * 8, v, unit);
        __syncthreads();
    }
}

struct Args { const float* in[26]; float* out; unsigned char* ws; };
typedef const __attribute__((address_space(4))) Args* CArgs;
__device__ __forceinline__ CArgs opq_args(CArgs p) { asm volatile("" : "+s"(p)); return p; }
enum { I_X = 0, I_META, I_NMIX, I_NFFN, I_NFIN, I_WIN, I_MURW, I_W0, I_WUP, I_A0, I_AUP, I_GUP, I_KK, I_KA, I_RK, I_LNW, I_LNB, I_VDOWN, I_VMU, I_VUP, I_VRES0, I_WSB, I_WRW, I_WOUT, I_WF1, I_WF2 };

__device__ __forceinline__ void tr_item(const float* W, int ldw, int c0, int nblk, int item, bf16_t* D, int ldd, int r0, int mode, const float* gain, LAS float* scr, int lane) {
    const int kb = item / nblk, nb = item % nblk, k0 = 64 * kb, n0 = 32 * nb;
    float tv[32];
#pragma unroll
    for (int i = 0; i < 32; ++i) tv[i] = W[(size_t)(k0 + 2 * i + (lane >> 5)) * ldw + c0 + n0 + (lane & 31)];
#pragma unroll
    for (int i = 0; i < 32; ++i) { const int kk = 2 * i + (lane >> 5); float v = tv[i]; if (gain) v *= gain[k0 + kk]; scr[kk * 33 + (lane & 31)] = v; }
    asm volatile("s_waitcnt lgkmcnt(0)" ::: "memory");
    const int c = lane & 7;
#pragma unroll
    for (int j = 0; j < 4; ++j) {
        const int n = (lane >> 3) + 8 * j; const LAS float* s = scr + (8 * c) * 33 + n;
        u32x4 o; o.x = cvt_pk_bf16(s[0 * 33], s[1 * 33]); o.y = cvt_pk_bf16(s[2 * 33], s[3 * 33]); o.z = cvt_pk_bf16(s[4 * 33], s[5 * 33]); o.w = cvt_pk_bf16(s[6 * 33], s[7 * 33]);
        int drow;
        if (mode == 0) drow = r0 + n0 + n;
        else { const int col = c0 + n0 + n, isup = col >= FFH ? 1 : 0, jj = col - isup * FFH; drow = 8 * (jj >> 2) + 4 * isup + (jj & 3); }
        *(u32x4*)(D + (size_t)drow * ldd + k0 + 8 * c) = o;
    }
    asm volatile("s_waitcnt lgkmcnt(0)" ::: "memory");
}
__device__ __forceinline__ void tr_job(const float* W, int K, int ldw, int c0, int ncols, bf16_t* D, int ldd, int r0, int mode, const float* gain, LAS float* scr, int lane, int gw, int ngw) {
    const int nblk = ncols / 32, nitems = (K / 64) * nblk;
    for (int it = gw; it < nitems; it += ngw) tr_item(W, ldw, c0, nblk, it, D, ldd, r0, mode, gain, scr, lane);
}
__device__ __forceinline__ void zero16(void* p, size_t bytes, int gtid, int ngt) {
    u32x4* q = (u32x4*)p; const size_t n = bytes / 16;
    for (size_t i = gtid; i < n; i += ngt) q[i] = (u32x4){0u, 0u, 0u, 0u};
}
__device__ __forceinline__ void convert_mix_weights(CArgs a, int l, LAS unsigned char* lds, int wave, int lane, int gw, int ngw) {
    unsigned char* ws = a->ws;
    LAS float* scr = (LAS float*)(lds + wave * 8448);
    const float* win = a->in[I_WIN] + (size_t)l * DM * INCOLS; const float* gmix = a->in[I_NMIX] + l * DM;
    bf16_t* W1A = (bf16_t*)(ws + OFF_W1A);
    tr_job(win, DM, INCOLS, 0, 1024, W1A, 1024, 0, 0, gmix, scr, lane, gw, ngw);
    tr_job(win, DM, INCOLS, 1536, RWCOLS, W1A, 1024, 1024, 0, gmix, scr, lane, gw, ngw);
    const int gtid = gw * 64 + lane, ngt = ngw * 64;
    if (l > 0) { tr_job(a->in[I_VDOWN] + (size_t)(l - 1) * DM * 32, DM, 32, 0, 32, W1A, 1024, 1024 + RWCOLS, 0, gmix, scr, lane, gw, ngw);
                 zero16(W1A + (size_t)(1024 + RWCOLS + 32) * 1024, (size_t)(3072 - 1024 - RWCOLS - 32) * 1024 * 2, gtid, ngt); }
    else zero16(W1A + (size_t)(1024 + RWCOLS) * 1024, (size_t)(3072 - 1024 - RWCOLS) * 1024 * 2, gtid, ngt);
    tr_job(win, DM, INCOLS, 1024, 512, (bf16_t*)(ws + OFF_WV), 1024, 0, 0, gmix, scr, lane, gw, ngw);
    tr_job(win, DM, INCOLS, 3360, 2048, (bf16_t*)(ws + OFF_WG), 1024, 0, 0, gmix, scr, lane, gw, ngw);
    tr_job(a->in[I_WSB] + (size_t)l * 512 * 1024, 512, 1024, 0, 1024, (bf16_t*)(ws + OFF_WSB), 512, 0, 0, nullptr, scr, lane, gw, ngw);
    tr_job(a->in[I_WRW] + (size_t)l * 512 * 1024, 512, 1024, 0, 1024, (bf16_t*)(ws + OFF_WRW), 512, 0, 0, nullptr, scr, lane, gw, ngw);
    tr_job(a->in[I_WOUT] + (size_t)l * 1024 * 1024, 1024, 1024, 0, 1024, (bf16_t*)(ws + OFF_WO), 1024, 0, 0, nullptr, scr, lane, gw, ngw);
    bf16_t* WL = (bf16_t*)(ws + OFF_WL);
    const float* wup = a->in[I_WUP] + (size_t)l * 64 * 512; const float* aup = a->in[I_AUP] + (size_t)l * 64 * 512; const float* gup = a->in[I_GUP] + (size_t)l * 160 * 512;
    const float* vup = a->in[I_VUP] + (size_t)(l > 0 ? l - 1 : 0) * 32 * 512;
    for (int idx = gtid; idx < 2048 * 384; idx += ngt) {
        const int n = idx / 384, k = idx - n * 384, grp = n >> 9, cn = n & 511; float v = 0.f;
        if (grp == 0) { if (k < 64) v = wup[k * 512 + cn]; }
        else if (grp == 1) { if (k >= 64 && k < 128) v = aup[(k - 64) * 512 + cn]; }
        else if (grp == 2) { if (k >= 128 && k < 288) v = gup[(k - 128) * 512 + cn]; }
        else { if (l > 0 && k >= 288 && k < 320) v = vup[(k - 288) * 512 + cn]; }
        WL[idx] = f2bf(v);
    }
}
__device__ __forceinline__ void convert_ffn_weights(CArgs a, int l, LAS unsigned char* lds, int wave, int lane, int gw, int ngw) {
    LAS float* scr = (LAS float*)(lds + wave * 8448);
    tr_job(a->in[I_WF1] + (size_t)l * DM * 2 * FFH, DM, 2 * FFH, 0, 2 * FFH, (bf16_t*)(a->ws + OFF_WF1), 1024, 0, 1, a->in[I_NFFN] + l * DM, scr, lane, gw, ngw);
    tr_job(a->in[I_WF2] + (size_t)l * FFH * DM, FFH, DM, 0, DM, (bf16_t*)(a->ws + OFF_WF2), FFH, 0, 0, nullptr, scr, lane, gw, ngw);
}

__device__ __forceinline__ void init_rows(CArgs a, int lane, int gw, int ngw) {
    bf16_t* HB = (bf16_t*)(a->ws + OFF_HB); float* ssq = (float*)(a->ws + OFF_SSQ);
    for (int row0 = gw; row0 < MP; row0 += 4 * ngw) {
        f32x4 v[4][4]; float s[4];
#pragma unroll
        for (int k = 0; k < 4; ++k) { const int row = row0 + k * ngw; s[k] = 0.f;
            if (row < T) { const int b = row / LT, t = row - b * LT;
                const float* src = t < NMETA ? a->in[I_META] + (size_t)t * DM : a->in[I_X] + ((size_t)b * SEQ + (t - NMETA)) * DM;
#pragma unroll
                for (int j = 0; j < 4; ++j) v[k][j] = *((const f32x4*)src + lane + 64 * j);
            } else {
#pragma unroll
                for (int j = 0; j < 4; ++j) v[k][j] = (f32x4){0.f, 0.f, 0.f, 0.f};
            } }
#pragma unroll
        for (int k = 0; k < 4; ++k) { const int row = row0 + k * ngw;
            if (row < MP) {
#pragma unroll
                for (int j = 0; j < 4; ++j) s[k] += (v[k][j].x * v[k][j].x + v[k][j].y * v[k][j].y) + (v[k][j].z * v[k][j].z + v[k][j].w * v[k][j].w);
                s[k] = wave_sum(s[k]);
#pragma unroll
                for (int j = 0; j < 4; ++j) {
                    u32x2 w; w.x = cvt_pk_bf16(v[k][j].x, v[k][j].y); w.y = cvt_pk_bf16(v[k][j].z, v[k][j].w); *((u32x2*)(HB + (size_t)row * DM) + lane + 64 * j) = w; }
                if (lane < 16) ssq[(size_t)row * 16 + lane] = lane == 0 ? s[k] : 0.f;
            } }
    }
}

__device__ __forceinline__ void sb_unit(const bf16_t* QK, const bf16_t* VT, bf16_t* YSB, int b, int h, int qb, int lane) {
    const int r32 = lane & 31, hi = lane >> 5, rowb = b * LT, q0 = qb * 32, tq = q0 + r32, tqc = tq < LT ? tq : LT - 1;
    bf16x8 qf[4];
    { const bf16_t* qp = QK + (size_t)(rowb + tqc) * 1024 + h * 64 + hi * 8;
#pragma unroll
      for (int s = 0; s < 4; ++s) qf[s] = *(const bf16x8*)(qp + s * 16); }
    bf16x8 lt[2];
#pragma unroll
    for (int ks = 0; ks < 2; ++ks)
#pragma unroll
        for (int i = 0; i < 8; ++i) lt[ks][i] = ((16 * ks + 4 * hi + (i & 3) + 8 * (i >> 2)) > r32) ? (short)0x3F80 : (short)0;
    f32x16 o0, o1;
#pragma unroll
    for (int r = 0; r < 16; ++r) { o0[r] = 0.f; o1[r] = 0.f; }
    float carry = 0.f;
    const bf16_t* vbase = VT + (size_t)(h * 64 + r32) * MP + rowb + 4 * hi;
#define SB_LOAD(kt_, KF, VLO, VHI) do { const int key0_ = (kt_) * 32; const int krow = (rowb + key0_ + r32) < T ? (rowb + key0_ + r32) : T - 1;     \
        const bf16_t* kp = QK + (size_t)krow * 1024 + 512 + h * 64 + hi * 8; \
        _Pragma("unroll") for (int s = 0; s < 4; ++s) KF[s] = *(const bf16x8*)(kp + s * 16); \
        _Pragma("unroll") for (int mt = 0; mt < 2; ++mt) _Pragma("unroll") for (int ks = 0; ks < 2; ++ks) { const int c0 = rowb + 4 * hi + key0_ + 16 * ks, c1 = c0 + 8; const bf16_t* vrow = VT + (size_t)(h * 64 + r32 + mt * 32) * MP; \
            VLO[mt][ks] = *(const s16x4*)(vrow + (c0 < T - 4 ? c0 : T - 4)); VHI[mt][ks] = *(const s16x4*)(vrow + (c1 < T - 4 ? c1 : T - 4)); } } while (0)
    bf16x8 kf[4]; s16x4 vlo[2][2], vhi[2][2];
    SB_LOAD(qb, kf, vlo, vhi);
    for (int kt = qb; kt >= 0; --kt) {
        const int key0 = kt * 32;
        bf16x8 kfn[4]; s16x4 vlon[2][2], vhin[2][2];
        SB_LOAD((kt > 0 ? kt - 1 : 0), kfn, vlon, vhin);
        bf16x8 vf[2][2];
#pragma unroll
        for (int mt = 0; mt < 2; ++mt)
#pragma unroll
            for (int ks = 0; ks < 2; ++ks) vf[mt][ks] = (bf16x8){vlo[mt][ks][0], vlo[mt][ks][1], vlo[mt][ks][2], vlo[mt][ks][3], vhi[mt][ks][0], vhi[mt][ks][1], vhi[mt][ks][2], vhi[mt][ks][3]};
        f32x16 st;
#pragma unroll
        for (int r = 0; r < 16; ++r) st[r] = 0.f;
#pragma unroll
        for (int s = 0; s < 4; ++s) st = __builtin_amdgcn_mfma_f32_32x32x16_bf16(kf[s], qf[s], st, 0, 0, 0);
        float sp[16]; float loc = 0.f;
#pragma unroll
        for (int r = 0; r < 16; ++r) {
            const int key = key0 + (r & 3) + 8 * (r >> 2) + 4 * hi;
            const float z = st[r];
            float v = fmaxf(z, 0.f) + __builtin_amdgcn_logf(1.f + __builtin_amdgcn_exp2f(-fabsf(z)));
            v = (key < tq) ? v : 0.f;
            sp[r] = v; loc += v;
        }
        u32x4 sb0, sb1;
        sb0.x = cvt_pk_bf16(sp[0], sp[1]); sb0.y = cvt_pk_bf16(sp[2], sp[3]); sb0.z = cvt_pk_bf16(sp[4], sp[5]); sb0.w = cvt_pk_bf16(sp[6], sp[7]);
        sb1.x = cvt_pk_bf16(sp[8], sp[9]); sb1.y = cvt_pk_bf16(sp[10], sp[11]); sb1.z = cvt_pk_bf16(sp[12], sp[13]); sb1.w = cvt_pk_bf16(sp[14], sp[15]);
        f32x16 bt;
#pragma unroll
        for (int r = 0; r < 16; ++r) bt[r] = carry;
        bt = __builtin_amdgcn_mfma_f32_32x32x16_bf16(lt[0], __builtin_bit_cast(bf16x8, sb0), bt, 0, 0, 0);
        bt = __builtin_amdgcn_mfma_f32_32x32x16_bf16(lt[1], __builtin_bit_cast(bf16x8, sb1), bt, 0, 0, 0);
        float p[16];
#pragma unroll
        for (int r = 0; r < 16; ++r) {
            const int key = key0 + (r & 3) + 8 * (r >> 2) + 4 * hi;
            const float la = st[r] - sp[r] - bt[r];
            p[r] = (key < tq) ? __builtin_amdgcn_exp2f(la) : 0.f;
        }
        u32x4 pb0, pb1;
        pb0.x = cvt_pk_bf16(p[0], p[1]); pb0.y = cvt_pk_bf16(p[2], p[3]); pb0.z = cvt_pk_bf16(p[4], p[5]); pb0.w = cvt_pk_bf16(p[6], p[7]);
        pb1.x = cvt_pk_bf16(p[8], p[9]); pb1.y = cvt_pk_bf16(p[10], p[11]); pb1.z = cvt_pk_bf16(p[12], p[13]); pb1.w = cvt_pk_bf16(p[14], p[15]);
        o0 = __builtin_amdgcn_mfma_f32_32x32x16_bf16(vf[0][0], __builtin_bit_cast(bf16x8, pb0), o0, 0, 0, 0);
        o0 = __builtin_amdgcn_mfma_f32_32x32x16_bf16(vf[0][1], __builtin_bit_cast(bf16x8, pb1), o0, 0, 0, 0);
        o1 = __builtin_amdgcn_mfma_f32_32x32x16_bf16(vf[1][0], __builtin_bit_cast(bf16x8, pb0), o1, 0, 0, 0);
        o1 = __builtin_amdgcn_mfma_f32_32x32x16_bf16(vf[1][1], __builtin_bit_cast(bf16x8, pb1), o1, 0, 0, 0);
        carry += loc + __shfl_xor(loc, 32);
#pragma unroll
        for (int s = 0; s < 4; ++s) kf[s] = kfn[s];
#pragma unroll
        for (int mt = 0; mt < 2; ++mt)
#pragma unroll
            for (int ks = 0; ks < 2; ++ks) { vlo[mt][ks] = vlon[mt][ks]; vhi[mt][ks] = vhin[mt][ks]; }
        if (__all(carry > 170.f)) break;
    }
#undef SB_LOAD
    if (tq < LT) {
        bf16_t* op = YSB + (size_t)(rowb + tq) * 512 + h * 64 + 4 * hi;
#pragma unroll
        for (int rg = 0; rg < 4; ++rg) {
            u32x2 w0; w0.x = cvt_pk_bf16(o0[4 * rg], o0[4 * rg + 1]); w0.y = cvt_pk_bf16(o0[4 * rg + 2], o0[4 * rg + 3]);
            u32x2 w1; w1.x = cvt_pk_bf16(o1[4 * rg], o1[4 * rg + 1]); w1.y = cvt_pk_bf16(o1[4 * rg + 2], o1[4 * rg + 3]);
            *(u32x2*)(op + 8 * rg) = w0; *(u32x2*)(op + 32 + 8 * rg) = w1;
        }
    }
}

__device__ __forceinline__ void lora_act(CArgs a, int l, int lane, int gw, int ngw) {
    const bf16_t* RW = (const bf16_t*)(a->ws + OFF_E); bf16_t* A2 = (bf16_t*)(a->ws + OFF_I);
    float mu[5];
#pragma unroll
    for (int i = 0; i < 5; ++i) { const int col = lane + 64 * i; mu[i] = col < 288 ? a->in[I_MURW][l * RWCOLS + 1536 + col] : (l > 0 && col < 320 ? a->in[I_VMU][(l - 1) * 32 + col - 288] : 0.f); }
    for (int row0 = gw; row0 < T; row0 += 4 * ngw) {
        bf16_t ux[4][5], up[4][5]; float pm[4];
#pragma unroll
        for (int j = 0; j < 4; ++j) { const int row = row0 + j * ngw < T ? row0 + j * ngw : T - 1; const int t = row % LT;
            const bf16_t* cur = RW + (size_t)row * 2048 + 1536; const bf16_t* prv = t > 0 ? cur - 2048 : cur; pm[j] = t > 0 ? 1.f : 0.f;
#pragma unroll
            for (int i = 0; i < 5; ++i) { ux[j][i] = cur[lane + 64 * i]; up[j][i] = prv[lane + 64 * i]; } }
#pragma unroll
        for (int j = 0; j < 4; ++j) { const int row = row0 + j * ngw;
            if (row < T) {
#pragma unroll
                for (int i = 0; i < 6; ++i) {
                    const int col = lane + 64 * i; float v = 0.f;
                    if (i < 5) {
                        const float x = bf2f(ux[j][i]), xp = pm[j] * bf2f(up[j][i]);
                        const float s = x + (xp - x) * mu[i];
                        if (col < 64) v = 1.f - 2.f * __builtin_amdgcn_rcpf(fexp(2.f * s) + 1.f);
                        else if (col < 128) v = s;
                        else if (col < 288) v = fsigmoid(s);
                        else v = s;
                    }
                    A2[(size_t)row * 384 + col] = f2bf(v);
                }
            } }
    }
}

__device__ __forceinline__ void rw_finalise(CArgs a, int l, int lane, int gw, int ngw) {
    bf16_t* RW = (bf16_t*)(a->ws + OFF_E); bf16_t* LO = (bf16_t*)(a->ws + OFF_F); bf16_t* RFIN = (bf16_t*)(a->ws + OFF_I);
    bf16_t* VFIRST = (bf16_t*)(a->ws + OFF_VFIRST); bf16_t* VMIX = (bf16_t*)(a->ws + OFF_HH); float* BONUS = (float*)(a->ws + OFF_BONUS);
    const float* mu = a->in[I_MURW] + l * RWCOLS; const float* w0 = a->in[I_W0] + l * 512; const float* a0 = a->in[I_A0] + l * 512; const float* kkp = a->in[I_KK] + l * 512;
    const float* kap = a->in[I_KA] + l * 512; const float* rkp = a->in[I_RK] + l * 512; const float* vr0 = a->in[I_VRES0] + (l > 0 ? l - 1 : 0) * 512;
    float c_mr[8], c_mk[8], c_mv[8], c_w0[8], c_a0[8], c_kk[8], c_ka[8], c_rk[8], c_v0[8];
#pragma unroll
    for (int h = 0; h < 8; ++h) { const int c = h * 64 + lane; c_mr[h] = mu[c]; c_mk[h] = mu[512 + c]; c_mv[h] = mu[1024 + c]; c_w0[h] = w0[c]; c_a0[h] = a0[c]; c_kk[h] = kkp[c]; c_ka[h] = kap[c]; c_rk[h] = rkp[c]; c_v0[h] = vr0[c]; }
    for (int row = gw; row < T; row += ngw) {
        const int t = row % LT;
        bf16_t u_r[8], u_k[8], u_v[8], u_rp[8], u_kp[8], u_vp[8], u_w[8], u_a[8], u_g[8], u_f[8];
        const size_t prow = t > 0 ? (size_t)row - 1 : (size_t)row; const float pm = t > 0 ? 1.f : 0.f;
#pragma unroll
        for (int h = 0; h < 8; ++h) { const int c = h * 64 + lane; const bf16_t* cur = RW + (size_t)row * 2048 + c; const bf16_t* prv = RW + prow * 2048 + c; const bf16_t* lo = LO + (size_t)row * 2048 + c;
            u_r[h] = cur[0]; u_k[h] = cur[512]; u_v[h] = cur[1024]; u_rp[h] = prv[0]; u_kp[h] = prv[512]; u_vp[h] = prv[1024]; u_w[h] = lo[0]; u_a[h] = lo[512];
            u_g[h] = lo[1536]; u_f[h] = VFIRST[(size_t)row * 512 + c]; }
        float q_r[8], q_k[8], q_v[8], q_rp[8], q_kp[8], q_vp[8], q_w[8], q_a[8], q_g[8], q_f[8];
#pragma unroll
        for (int h = 0; h < 8; ++h) { q_r[h] = bf2f(u_r[h]); q_k[h] = bf2f(u_k[h]); q_v[h] = bf2f(u_v[h]); q_rp[h] = pm * bf2f(u_rp[h]); q_kp[h] = pm * bf2f(u_kp[h]); q_vp[h] = pm * bf2f(u_vp[h]);
            q_w[h] = bf2f(u_w[h]); q_a[h] = bf2f(u_a[h]); q_g[h] = bf2f(u_g[h]); q_f[h] = bf2f(u_f[h]); }
#pragma unroll
        for (int h = 0; h < 8; ++h) { const int c = h * 64 + lane;
            const float r = q_r[h] + (q_rp[h] - q_r[h]) * c_mr[h], kr = q_k[h] + (q_kp[h] - q_k[h]) * c_mk[h]; float vr = q_v[h] + (q_vp[h] - q_v[h]) * c_mv[h];
            const float wl = -fsoftplus(-(c_w0[h] + q_w[h])) - 0.5f, ew = fexp(wl), av = fsigmoid(c_a0[h] + q_a[h]);
            if (l == 0) VFIRST[(size_t)row * 512 + c] = f2bf(vr); else vr += (q_f[h] - vr) * fsigmoid(c_v0[h] + q_g[h]);
            float kk = kr * c_kk[h]; kk = kk * __builtin_amdgcn_rsqf(fmaxf(wave_sum(kk * kk), 1e-24f));
            const float k2 = kr * (1.f + (av - 1.f) * c_ka[h]); const float bon = wave_sum(r * k2 * c_rk[h]);
            bf16_t* lo = LO + (size_t)row * 2048 + c;
            RFIN[(size_t)row * 512 + c] = f2bf(r); RW[(size_t)row * 2048 + 1536 + c] = f2bf(k2); VMIX[(size_t)row * 512 + c] = f2bf(vr);
            lo[0] = f2bf(-kk); lo[512] = f2bf(kk * av); lo[1536] = f2bf(ew);
            if (lane == 0) BONUS[(size_t)row * 8 + h] = bon; }
    }
}

constexpr int TC = 32;
constexpr int RW_BUF = 14336;
__device__ __forceinline__ float row16_sum(float v) {
    v += dpp0<0xB1, 0xF>(v); v += dpp0<0x4E, 0xF>(v); v += dpp0<0x141, 0xF>(v); v += dpp0<0x140, 0xF>(v); return v;
}
#define RW_BAR() do { asm volatile("s_waitcnt lgkmcnt(0)" ::: "memory"); __builtin_amdgcn_s_barrier(); asm volatile("" ::: "memory"); } while (0)
__device__ __forceinline__ void rwkv_phase(CArgs a, int l, LAS unsigned char* lds, int wave, int lane) {
    const bf16_t* RW = (const bf16_t*)(a->ws + OFF_E); const bf16_t* LO = (const bf16_t*)(a->ws + OFF_F);
    bf16_t* VFIRST = (bf16_t*)(a->ws + OFF_VFIRST); bf16_t* VMIX = (bf16_t*)(a->ws + OFF_HH);
    float* Y = (float*)(a->ws + OFF_G); float* BONUS = (float*)(a->ws + OFF_BONUS);
    LAS float* L0 = (LAS float*)lds;
    constexpr int NCH = (LT + TC - 1) / TC;
    for (int u = blockIdx.x; u < 256; u += gridDim.x) {
        const int bh = (u & 7) * 4 + (u >> 6), rg = (u >> 3) & 7, b = bh >> 3, h = bh & 7;
        if (wave >= 4) {
            const int c = h * 64 + lane, pw = wave - 4;
            const bf16_t* RFIN = (const bf16_t*)(a->ws + OFF_I);
            unsigned x_r[4], x_w[4], x_k[4], x_n[4], x_b[4], x_v[4], y_r[4], y_w[4], y_k[4], y_n[4], y_b[4], y_v[4];
            const int ts = lane >> 5, c2 = h * 64 + 2 * (lane & 31);
            typedef float f32x2p __attribute__((ext_vector_type(2)));
#define RW_LOAD(S, t0_) do { _Pragma("unroll") for (int g = 0; g < 4; ++g) { int t = (t0_) + pw + 4 * (2 * g + ts); t = t < LT ? t : LT - 1;     \
                const size_t row = (size_t)b * LT + t; const bf16_t* lo = LO + row * 2048 + c2; \
                { const int to_ = (t0_) + pw + 4 * (2 * g + ts); const int tr_ = (to_ < LT ? to_ : LT) - 1; const size_t rowr = (size_t)b * LT + (tr_ > 0 ? tr_ : 0); S##_r[g] = *(const unsigned*)(RFIN + rowr * 512 + c2); }     \
                S##_w[g] = *(const unsigned*)(lo + 1536); S##_k[g] = *(const unsigned*)(RW + row * 2048 + 1536 + c2); \
                S##_n[g] = *(const unsigned*)lo; S##_b[g] = *(const unsigned*)(lo + 512); S##_v[g] = *(const unsigned*)(VMIX + row * 512 + c2); } } while (0)
#define RW_FINAL(S, t0_, buf_) do { LAS float* B_ = L0 + (buf_) * RW_BUF; _Pragma("unroll") for (int g = 0; g < 4; ++g) { const int tt = pw + 4 * (2 * g + ts); \
                *(LAS f32x4*)(B_ + tt * 128 + 4 * (lane & 31)) = (f32x4){fexp(-bflo(S##_w[g])), fexp(-bfhi(S##_w[g])), bflo(S##_k[g]), bfhi(S##_k[g])}; \
                *(LAS f32x4*)(B_ + 4096 + tt * 128 + 4 * (lane & 31)) = (f32x4){bflo(S##_n[g]), bflo(S##_r[g]), bfhi(S##_n[g]), bfhi(S##_r[g])};     \
                *(LAS f32x2p*)(B_ + 8192 + tt * 128 + 2 * (lane & 31)) = (f32x2p){bflo(S##_b[g]), bfhi(S##_b[g])}; \
                *(LAS f32x2p*)(B_ + 12288 + tt * 64 + 2 * (lane & 31)) = (f32x2p){bflo(S##_v[g]), bfhi(S##_v[g])}; } } while (0)
            RW_LOAD(x, 0); RW_LOAD(y, TC); RW_FINAL(x, 0, 0);
            RW_BAR();
            for (int ci = 0; ci < NCH; ++ci) {
                const int t0 = ci * TC;
                if (ci & 1) { if (ci + 2 < NCH) RW_LOAD(y, t0 + 2 * TC); if (ci + 1 < NCH) RW_FINAL(x, t0 + TC, 0); }
                else        { if (ci + 2 < NCH) RW_LOAD(x, t0 + 2 * TC); if (ci + 1 < NCH) RW_FINAL(y, t0 + TC, 1); }
                RW_BAR();
            }
#undef RW_LOAD
#undef RW_FINAL
        } else {
            const int q = lane & 31, rho = rg * 8 + wave * 2 + (lane >> 5);
            typedef float f32x2v __attribute__((ext_vector_type(2)));
            f32x2v s = (f32x2v){0.f, 0.f};
            RW_BAR();
            for (int ci = 0; ci < NCH; ++ci) {
                const int t0 = ci * TC, n = (LT - t0) < TC ? (LT - t0) : TC;
                const LAS float* B_ = L0 + (ci & 1) * RW_BUF;
                float yb = 0.f, yb1 = 0.f, ylast = 0.f; const int q16 = lane & 15; const bool yrow = (lane & 16) != 0;
#define RW_SHIFTIN(acc_, v_) __builtin_bit_cast(float, __builtin_amdgcn_update_dpp(__builtin_bit_cast(int, v_), __builtin_bit_cast(int, acc_), 0x111, 0xA, 0xF, false))
#define RW_ISSUE_A(tt_, R2_, WK_, NB_, V2_) do { \
                    asm volatile("ds_read_b128 %0, %1 offset:%2" : "=v"(NB_) : "v"(abase), "i"(16384 + (tt_) * 512)); asm volatile("ds_read_b128 %0, %1 offset:%2" : "=v"(WK_) : "v"(abase), "i"((tt_) * 512)); \
                    asm volatile("ds_read2st64_b32 %0, %1 offset0:%2 offset1:%3" : "=v"(V2_) : "v"(vbase), "i"(192 + (tt_)), "i"(193 + (tt_))); \
                    asm volatile("ds_read2st64_b64 %0, %1 offset0:%2 offset1:%3" : "=v"(R2_) : "v"(rbase), "i"(64 + (tt_)), "i"(65 + (tt_))); } while (0)
#define RW_ISSUE_B(tt_, WK_, NB_) do { \
                    asm volatile("ds_read_b128 %0, %1 offset:%2" : "=v"(NB_) : "v"(abase), "i"(16384 + (tt_) * 512)); asm volatile("ds_read_b128 %0, %1 offset:%2" : "=v"(WK_) : "v"(abase), "i"((tt_) * 512)); } while (0)
#define RW_WAIT_A(NN_, R2_, WK_, NB_, V2_) asm volatile("s_waitcnt lgkmcnt(" #NN_ ")" : "+v"(R2_), "+v"(WK_), "+v"(NB_), "+v"(V2_))
#define RW_WAIT_B(NN_, WK_, NB_) asm volatile("s_waitcnt lgkmcnt(" #NN_ ")" : "+v"(WK_), "+v"(NB_))
#define RW_SUM32_2(x_, y_) do { x_ += dpp0<0xB1, 0xF>(x_); y_ += dpp0<0xB1, 0xF>(y_); x_ += dpp0<0x4E, 0xF>(x_); y_ += dpp0<0x4E, 0xF>(y_); \
                    x_ += dpp0<0x141, 0xF>(x_); y_ += dpp0<0x141, 0xF>(y_); x_ += dpp0<0x140, 0xF>(x_); y_ += dpp0<0x140, 0xF>(y_); \
                      \
                    const auto sw_ = __builtin_amdgcn_permlane16_swap(__float_as_uint(x_), __float_as_uint(y_), false, false); \
                    const float cb_ = __uint_as_float(sw_[0]) + __uint_as_float(sw_[1]); y_ = cb_; \
                    x_ = __builtin_bit_cast(float, __builtin_amdgcn_update_dpp(__builtin_bit_cast(int, cb_), __builtin_bit_cast(int, cb_), 0x142, 0xA, 0xF, false)); } while (0)
#define RW_STEP(tt_, Bv_, WK_, NR_, V_) do { const f32x2v W_ = (f32x2v){WK_.x, WK_.y}, K_ = (f32x2v){WK_.z, WK_.w}; \
                    const f32x2v tw_ = s * W_ + V_ * K_;     \
                    f32x2v p_ = (f32x2v){s.x, s.x} * (f32x2v){NR_.x, NR_.y}; p_ = (f32x2v){s.y, s.y} * (f32x2v){NR_.z, NR_.w} + p_;     \
                    float sa = p_.x, yv = p_.y; RW_SUM32_2(sa, yv); \
                    if ((tt_) == 0) ylast = yv; else if ((tt_) <= 16) yb = RW_SHIFTIN(yb, yv); else yb1 = RW_SHIFTIN(yb1, yv);     \
                    s = tw_ + sa * Bv_; } while (0)
                static_assert(TC == 32, "asm offsets assume TC = 32");
                const unsigned abase = (unsigned)(size_t)B_ + 16u * (unsigned)q, rbase = (unsigned)(size_t)B_ + 8u * (unsigned)q, vbase = (unsigned)(size_t)B_ + 4u * (unsigned)rho;
                f32x4 r2, wkA, nbA, wkB, nbB; f32x2v v2;
#define RW_PAIR(tt_) do { RW_ISSUE_B((tt_) + 1, wkB, nbB); RW_WAIT_A(2, r2, wkA, nbA, v2); \
                    const f32x2v rA_ = (f32x2v){r2.x, r2.y}, rB_ = (f32x2v){r2.z, r2.w}; const float vA_ = v2.x, vB_ = v2.y; RW_STEP((tt_), rA_, wkA, nbA, vA_); \
                    RW_ISSUE_A(((tt_) + 2 < TC ? (tt_) + 2 : (tt_)), r2, wkA, nbA, v2); RW_WAIT_B(4, wkB, nbB); RW_STEP((tt_) + 1, rB_, wkB, nbB, vB_); } while (0)
                RW_ISSUE_A(0, r2, wkA, nbA, v2);
                RW_PAIR(0); RW_PAIR(2); RW_PAIR(4); RW_PAIR(6); RW_PAIR(8); RW_PAIR(10); RW_PAIR(12); RW_PAIR(14);
                if (n > 16) { RW_PAIR(16); RW_PAIR(18); RW_PAIR(20); RW_PAIR(22); RW_PAIR(24); RW_PAIR(26); RW_PAIR(28); RW_PAIR(30); }
#undef RW_PAIR
                RW_WAIT_A(0, r2, wkA, nbA, v2);
#undef RW_ISSUE_A
#undef RW_ISSUE_B
#undef RW_WAIT_A
#undef RW_WAIT_B
#undef RW_STEP
#undef RW_SHIFTIN
                if (yrow) {
                    const int c0 = n - 1 < 16 ? n - 1 : 16, c1 = n > 17 ? n - 17 : 0;
                    if (q16 < c0) Y[((size_t)b * LT + t0 + c0 - 1 - q16) * 512 + h * 64 + rho] = yb;
                    if (q16 < c1) Y[((size_t)b * LT + t0 + 16 + c1 - 1 - q16) * 512 + h * 64 + rho] = yb1;
                    if (ci > 0 && q16 == 0) Y[((size_t)b * LT + t0 - 1) * 512 + h * 64 + rho] = ylast;
                }
                RW_BAR();
            }
            { const LAS float* Bl_ = L0 + ((NCH - 1) & 1) * RW_BUF + 4096 + (LT - (NCH - 1) * TC) * 128 + 4 * q; float yv = s.x * Bl_[1] + s.y * Bl_[3], dummy = 0.f; RW_SUM32_2(yv, dummy);
              if (q == 0) Y[((size_t)b * LT + LT - 1) * 512 + h * 64 + rho] = yv; }
#undef RW_SUM32_2
        }
    }
}

__device__ __forceinline__ void rw_post(CArgs a, int l, int lane, int gw, int ngw) {
    const float* Y = (const float*)(a->ws + OFF_G); const bf16_t* LO = (const bf16_t*)(a->ws + OFF_F); const bf16_t* VMIX = (const bf16_t*)(a->ws + OFF_HH);
    const float* BONUS = (const float*)(a->ws + OFF_BONUS); bf16_t* YRW = (bf16_t*)(a->ws + OFF_I);
    float lw[NH], lb[NH];
#pragma unroll
    for (int h = 0; h < NH; ++h) { lw[h] = a->in[I_LNW][l * 512 + h * 64 + lane]; lb[h] = a->in[I_LNB][l * 512 + h * 64 + lane]; }
    float yv[NH], bo[NH]; bf16_t vm[NH], gg[NH];
#define RP_LOAD(r_, YV, BO, VM, GG) do { const int rr_ = (r_) < T ? (r_) : T - 1; _Pragma("unroll") for (int h = 0; h < NH; ++h) { const int c = h * 64 + lane; \
        YV[h] = Y[(size_t)rr_ * 512 + c]; BO[h] = BONUS[(size_t)rr_ * 8 + h]; VM[h] = VMIX[(size_t)rr_ * 512 + c]; GG[h] = LO[(size_t)rr_ * 2048 + 1024 + c]; } } while (0)
    RP_LOAD(gw, yv, bo, vm, gg);
    for (int row = gw; row < T; row += ngw) {
        float yn_[NH], bn_[NH]; bf16_t vn_[NH], gn_[NH];
        RP_LOAD(row + ngw, yn_, bn_, vn_, gn_);
#pragma unroll
        for (int h = 0; h < NH; ++h) {
            const int c = h * 64 + lane;
            const float y = yv[h];
            const float mean = wave_sum(y) * (1.f / 64.f), d = y - mean;
            const float var = wave_sum(d * d) * (1.f / 64.f);
            const float yn = d * rsqrtf(var + GN_EPS) * lw[h] + lb[h];
            const float o = (yn + bo[h] * bf2f(vm[h])) * bf2f(gg[h]);
            YRW[(size_t)row * 512 + c] = f2bf(o);
        }
#pragma unroll
        for (int h = 0; h < NH; ++h) { yv[h] = yn_[h]; bo[h] = bn_[h]; vm[h] = vn_[h]; gg[h] = gn_[h]; }
    }
#undef RP_LOAD
}

__device__ __forceinline__ void final_out(CArgs a, int lane, int gw, int ngw) {
    const bf16_t* HB = (const bf16_t*)(a->ws + OFF_HB); const float* ssq = (const float*)(a->ws + OFF_SSQ);
    f32x4 g[4];
#pragma unroll
    for (int j = 0; j < 4; ++j) g[j] = *((const f32x4*)a->in[I_NFIN] + lane + 64 * j);
    for (int o0 = gw; o0 < NB * SEQ; o0 += 4 * ngw) {
        u32x2 hv[4][4]; float rs[4];
#pragma unroll
        for (int k = 0; k < 4; ++k) { const int o = o0 + k * ngw < NB * SEQ ? o0 + k * ngw : NB * SEQ - 1; const int b = o / SEQ, s = o - b * SEQ, row = b * LT + NMETA + s;
            rs[k] = row_rstd(ssq, row);
#pragma unroll
            for (int j = 0; j < 4; ++j) hv[k][j] = *((const u32x2*)(HB + (size_t)row * DM) + lane + 64 * j); }
#pragma unroll
        for (int k = 0; k < 4; ++k) { const int o = o0 + k * ngw;
            if (o < NB * SEQ) {
#pragma unroll
                for (int j = 0; j < 4; ++j) { const f32x4 v = (f32x4){bflo(hv[k][j].x), bfhi(hv[k][j].x), bflo(hv[k][j].y), bfhi(hv[k][j].y)}; *((f32x4*)(a->out + (size_t)o * DM) + lane + 64 * j) = v * rs[k] * g[j]; }
            } }
    }
}

#define RLX_AGENT __ATOMIC_RELAXED, __HIP_MEMORY_SCOPE_AGENT
#define XB_TMO      128
#define XB_XCNT(j)  (256  + 64 * (j))
#define XB_XSUB(j)  (1280 + 64 * (j))
#define XB_XGEN(j)  (2304 + 64 * (j))
#define XB_TOP      3328
#define XB_TOPGEN   3392
#define XCD_BAR_WORDS 3456
#define XB_SPIN_CAP (1u << 18)

__device__ __forceinline__ unsigned xb_ld(unsigned* p)              { return __hip_atomic_load(p, __ATOMIC_RELAXED, __HIP_MEMORY_SCOPE_AGENT); }
__device__ __forceinline__ unsigned xb_add(unsigned* p, unsigned v) { return __hip_atomic_fetch_add(p, v, __ATOMIC_RELAXED, __HIP_MEMORY_SCOPE_AGENT); }
__device__ __forceinline__ unsigned xb_xcc_id() { return (unsigned)__builtin_amdgcn_s_getreg((3 << 11) | 20) & 0xFu; }
#define XB_SPIN(cond, bar) do { unsigned _sp = 0; while (cond) { __builtin_amdgcn_s_sleep(1); \
    if ((++_sp & 255u) == 0u) { if (xb_ld(&(bar)[XB_TMO])) break; if (_sp > XB_SPIN_CAP) { atomicAdd(&(bar)[XB_TMO], 1u); break; } } } } while (0)

struct XcdBarrier {
    unsigned* bar; unsigned x;
    volatile LAS unsigned* st;
};

__device__ __forceinline__ XcdBarrier xcd_barrier_post(unsigned* bar, volatile LAS unsigned* st) {
    XcdBarrier b; b.bar = bar; b.x = xb_xcc_id(); b.st = st;
    if (threadIdx.x == 0) (void)xb_add(&bar[XB_XCNT(b.x)], 1u);
    return b;
}
__device__ __forceinline__ void xcd_barrier_complete(unsigned* bar, unsigned x, unsigned& nloc, unsigned& nx) {
    const unsigned G = gridDim.x * gridDim.y * gridDim.z;
    unsigned sum, cnt, mine, sp = 0u;
    for (;;) {
        sum = 0u; cnt = 0u; mine = 0u;
#pragma unroll
        for (unsigned j = 0; j < 16; ++j) { const unsigned c = xb_ld(&bar[XB_XCNT(j)]); sum += c; cnt += (c > 0u) ? 1u : 0u; mine = (j == x) ? c : mine; }
        if (sum == G) break;
        __builtin_amdgcn_s_sleep(1);
        if ((++sp & 255u) == 0u) { if (xb_ld(&bar[XB_TMO])) break; if (sp > XB_SPIN_CAP) { atomicAdd(&bar[XB_TMO], 1u); break; } }
    }
    nloc = mine > 0u ? mine : 1u; nx = cnt > 0u ? cnt : 1u;
}

__device__ __forceinline__ void xcd_barrier(const XcdBarrier& b) {
    asm volatile("s_waitcnt vmcnt(0)" ::: "memory");
    __syncthreads();
    if (threadIdx.x == 0) {
        unsigned* bar = b.bar;
        __builtin_amdgcn_s_waitcnt(0);
        unsigned nloc = b.st[0], nx = b.st[1];
        if (nloc == 0u) { xcd_barrier_complete(bar, b.x, nloc, nx); b.st[0] = nloc; b.st[1] = nx; }
        const unsigned old = xb_add(&bar[XB_XSUB(b.x)], 1u);
        const unsigned gen = old / nloc;
        if (old + 1u == (gen + 1u) * nloc) {
            __builtin_amdgcn_fence(__ATOMIC_RELEASE, "agent");
            asm volatile("s_waitcnt vmcnt(0)" ::: "memory");
            const unsigned og = xb_add(&bar[XB_TOP], 1u);
            const unsigned tg = og / nx;
            if (og + 1u == (tg + 1u) * nx) xb_add(&bar[XB_TOPGEN], 1u);
            else XB_SPIN(xb_ld(&bar[XB_TOPGEN]) == tg, bar);
            __builtin_amdgcn_fence(__ATOMIC_ACQUIRE, "agent");
            xb_add(&bar[XB_XGEN(b.x)], 1u);
            asm volatile("s_waitcnt vmcnt(0)" ::: "memory");
        } else {
            XB_SPIN(xb_ld(&bar[XB_XGEN(b.x)]) == gen, bar);
            __builtin_amdgcn_fence(__ATOMIC_ACQUIRE, "agent");
            asm volatile("s_waitcnt vmcnt(0)" ::: "memory");
        }
    }
    __syncthreads();
}


#if PROBE_SYNC2
#define PROBE_EXTRA_SYNC asm volatile("s_waitcnt vmcnt(0)" ::: "memory"); grid.sync(); if (threadIdx.x == 0) { __builtin_amdgcn_fence(__ATOMIC_ACQUIRE, "agent"); asm volatile("s_waitcnt vmcnt(0)" ::: "memory"); } __syncthreads();
#else
#define PROBE_EXTRA_SYNC
#endif
#define GSYNC() do { asm volatile("s_waitcnt vmcnt(0)" ::: "memory"); grid.sync(); \
    if (threadIdx.x == 0) { __builtin_amdgcn_fence(__ATOMIC_ACQUIRE, "agent"); asm volatile("s_waitcnt vmcnt(0)" ::: "memory"); } \
    __syncthreads(); PROBE_EXTRA_SYNC } while (0)
#define XSYNC() xcd_barrier(xbar)
#ifndef AL1
#define AL1 false
#endif
#ifndef AL2
#define AL2 true
#endif
#ifndef AL3
#define AL3 true
#endif
#ifndef AL4
#define AL4 false
#endif
#ifndef AL5
#define AL5 true
#endif
#ifndef AL6
#define AL6 true
#endif
#ifndef AL7
#define AL7 true
#endif
#ifndef AL8
#define AL8 true
#endif
#ifndef AL9
#define AL9 true
#endif
#define COMMA ,
#ifndef GALIGN
#define GALIGN false
#endif
#ifndef GSP2
#define GSP2 true
#endif
#define GEMM_CALLX(EpiT, AL, gA, gB, gM, gN, gK, E) for (int rep_ = 0; rep_ < ((#AL)[2] == '7' || (#AL)[2] == '9' || (#AL)[2] == '6' ? 1 : 1 + PROBE_GEMM2); ++rep_) do { pg8::Gemm g_{(const bf16_t*)(gA), (const bf16_t*)(gB), (gM), (gN), (gK)}; pg8::StaticOrder S_; S_.init((gM), (gN), (int)gridDim.x, (int)blockIdx.x); \
    pg8::gemm_phase<EpiT, pg8::StaticOrder, AL, GSP2>(lds, g_, S_, (E)); } while (0)

__global__ void __launch_bounds__(NTHREADS, 2) fwd_megakernel(Args a_unused) {
    const CArgs ap = (CArgs)__builtin_amdgcn_kernarg_segment_ptr();
#define a opq_args(ap)
    extern __shared__ __attribute__((aligned(16))) unsigned char lds_raw[];
    LAS unsigned char* lds = (LAS unsigned char*)lds_raw;
    cg::grid_group grid = cg::this_grid();
    volatile LAS unsigned* bst = (volatile LAS unsigned*)(lds + 140032);
    if (threadIdx.x < 2) bst[threadIdx.x] = 0u;
    __syncthreads();
    const XcdBarrier xbar = xcd_barrier_post((unsigned*)(((CArgs)__builtin_amdgcn_kernarg_segment_ptr())->ws + OFF_BAR), bst);
    const int tid = threadIdx.x, lane = tid & 63, wave = __builtin_amdgcn_readfirstlane(tid >> 6);
    const int gw = blockIdx.x * NWAVES + wave, ngw = gridDim.x * NWAVES;
#define ws (opq_args(ap)->ws)
#define ssq ((float*)(ws + OFF_SSQ))

#if !defined(NO_P0)
    init_rows(a, lane, gw, ngw);
    convert_mix_weights(a, 0, lds, wave, lane, gw, ngw);
#endif
    GSYNC();

    for (int l = 0; l < DEPTH; ++l) {
#ifndef NO_PH1
        { EpiStore<0, true> E{(bf16_t*)(ws + OFF_G), 1024, (bf16_t*)(ws + OFF_E), 2048, 4, ssq, C2, 2};
          GEMM_CALLX(EpiStore<0 COMMA true>, AL2, ws + OFF_HB, ws + OFF_W1A, MB, 3072, 1024, E);
          TStore<0, true> TE{{(bf16_t*)(ws + OFF_G), 1024, (bf16_t*)(ws + OFF_E), 2048, 1024, ssq, C2, 512}};
          tail_gemm(lds, (const bf16_t*)(ws + OFF_HB) + (size_t)MB * 1024, (const bf16_t*)(ws + OFF_W1A), 1024, 3072, TE, wave, opq(lane), 128); }
        { EpiVT E{(bf16_t*)(ws + OFF_HH), MP, ssq};
          GEMM_CALLX(EpiVT, AL3, ws + OFF_WV, ws + OFF_HB, 512, MB, 1024, E);
          TVT TE{(bf16_t*)(ws + OFF_HH), MP, ssq};
          tail_gemm(lds, (const bf16_t*)(ws + OFF_HB) + (size_t)MB * 1024, (const bf16_t*)(ws + OFF_WV), 1024, 512, TE, wave, opq(lane), 176);
          { const int cb = gridDim.x >= 256 ? 128 : 0; if ((int)blockIdx.x >= cb) convert_ffn_weights(a, l, lds, wave, opq(lane), ((int)blockIdx.x - cb) * NWAVES + wave, ((int)gridDim.x - cb) * NWAVES); } }
#endif
        XSYNC();
#ifndef NO_PH2
        if (ngw == 2048) {
            if (gw < 32) { for (int k = 0; k < 3; ++k) sb_unit((const bf16_t*)(ws + OFF_G), (const bf16_t*)(ws + OFF_HH), (bf16_t*)(ws + OFF_J), gw >> 3, gw & 7, k < 2 ? k : 128, opq(lane)); }
            else { for (int k = 0; k < 2; ++k) { const int i = (gw - 32) + k * 2016, bh = i / 126, qb = 2 + (i - bh * 126); sb_unit((const bf16_t*)(ws + OFF_G), (const bf16_t*)(ws + OFF_HH), (bf16_t*)(ws + OFF_J), bh >> 3, bh & 7, qb, opq(lane)); } }
        } else
        for (int u = gw; u < NB * NH * 129; u += ngw) { const int bh = u / 129, qb = u - bh * 129; sb_unit((const bf16_t*)(ws + OFF_G), (const bf16_t*)(ws + OFF_HH), (bf16_t*)(ws + OFF_J), bh >> 3, bh & 7, qb, opq(lane)); }
        for (int rep_ = 0; rep_ < 1 + PROBE_MISC2; ++rep_) lora_act(a, l, opq(lane), gw, ngw);
#endif
        XSYNC();
#ifndef NO_PH3
        { EpiStore<0, false> E{(bf16_t*)(ws + OFF_F), 2048, (bf16_t*)(ws + OFF_F), 2048, 1 << 20, nullptr, 1.f, 0};
          GEMM_CALLX(EpiStore<0 COMMA false>, AL4, ws + OFF_I, ws + OFF_WL, MB, 2048, 384, E);
          TStore<0, false> TE{{(bf16_t*)(ws + OFF_F), 2048, (bf16_t*)(ws + OFF_F), 2048, 1 << 30, nullptr, 1.f, 0}};
          tail_gemm(lds, (const bf16_t*)(ws + OFF_I) + (size_t)MB * 384, (const bf16_t*)(ws + OFF_WL), 384, 2048, TE, wave, opq(lane)); }
#endif
        XSYNC();
        rw_finalise(a, l, opq(lane), gw, ngw);
        XSYNC();
#ifndef NO_PH4
        rwkv_phase(a, l, lds, wave, opq(lane));
#if PROBE_RW2
        rwkv_phase(a, l, lds, wave, opq(lane));
#endif
#endif
        XSYNC();
#ifndef NO_PH5
        for (int rep_ = 0; rep_ < 1 + PROBE_MISC2; ++rep_) rw_post(a, l, opq(lane), gw, ngw);
        { EpiStore<1, true> E{(bf16_t*)(ws + OFF_E), 2048, (bf16_t*)(ws + OFF_E), 2048, 1 << 20, ssq, 1.f, 0};
          GEMM_CALLX(EpiStore<1 COMMA true>, AL5, ws + OFF_HB, ws + OFF_WG, MB, 2048, 1024, E);
          TStore<1, true> TE{{(bf16_t*)(ws + OFF_E), 2048, (bf16_t*)(ws + OFF_E), 2048, 1 << 30, ssq, 1.f, 0}};
          tail_gemm(lds, (const bf16_t*)(ws + OFF_HB) + (size_t)MB * 1024, (const bf16_t*)(ws + OFF_WG), 1024, 2048, TE, wave, opq(lane)); }
#endif
        XSYNC();
#ifndef NO_PH6
        for (int br = 0; br < 2; ++br) {
            EpiGateMul E{(bf16_t*)(ws + OFF_F), (const bf16_t*)(ws + OFF_E), 2048, br * 1024, br};
            GEMM_CALLX(EpiGateMul, AL6, br ? ws + OFF_I : ws + OFF_J, br ? ws + OFF_WRW : ws + OFF_WSB, MB, 1024, 512, E);
            TGateMul TE{(bf16_t*)(ws + OFF_F), (const bf16_t*)(ws + OFF_E), 2048, br * 1024, br};
            tail_gemm(lds, (const bf16_t*)(br ? ws + OFF_I : ws + OFF_J) + (size_t)MB * 512, (const bf16_t*)(br ? ws + OFF_WRW : ws + OFF_WSB), 512, 1024, TE, wave, opq(lane));
        }
#endif
        XSYNC();
#ifndef NO_PH7
        { EpiResid E{(bf16_t*)(ws + OFF_HB), ssq + (size_t)MP * 16};
          GEMM_CALLX(EpiResid, AL7, ws + OFF_F, ws + OFF_WO, MB, 1024, 1024, E);
          TResid TE{(bf16_t*)(ws + OFF_HB), ssq + (size_t)MP * 16};
          tail_gemm(lds, (const bf16_t*)(ws + OFF_F) + (size_t)MB * 1024, (const bf16_t*)(ws + OFF_WO), 1024, 1024, TE, wave, opq(lane)); }
#endif
        XSYNC();
#ifndef NO_PH8
        { EpiSwiglu E{(bf16_t*)(ws + OFF_E), ssq + (size_t)MP * 16};
          GEMM_CALLX(EpiSwiglu, AL8, ws + OFF_HB, ws + OFF_WF1, MB, 2 * FFH, 1024, E);
          TSwiglu TE{(bf16_t*)(ws + OFF_E), ssq + (size_t)MP * 16};
          tail_gemm(lds, (const bf16_t*)(ws + OFF_HB) + (size_t)MB * 1024, (const bf16_t*)(ws + OFF_WF1), 1024, 2 * FFH, TE, wave, opq(lane), 128);
          { const int cb = gridDim.x >= 256 ? 128 : 0; if (l + 1 < DEPTH && (int)blockIdx.x >= cb) convert_mix_weights(a, l + 1, lds, wave, opq(lane), ((int)blockIdx.x - cb) * NWAVES + wave, ((int)gridDim.x - cb) * NWAVES); } }
#endif
        XSYNC();
#ifndef NO_PH9
        { EpiResid E{(bf16_t*)(ws + OFF_HB), ssq};
          GEMM_CALLX(EpiResid, AL9, ws + OFF_E, ws + OFF_WF2, MB, 1024, FFH, E);
          TResid TE{(bf16_t*)(ws + OFF_HB), ssq};
          tail_gemm(lds, (const bf16_t*)(ws + OFF_E) + (size_t)MB * FFH, (const bf16_t*)(ws + OFF_WF2), FFH, 1024, TE, wave, opq(lane)); }
#endif
        XSYNC();
    }
    final_out(a, opq(lane), gw, ngw);
#undef a
#undef ws
#undef ssq
}

extern "C" void kernel_launch(void* const* d_in, const int* in_sizes, int n_in, void* d_out, int out_size, void* d_ws, size_t ws_size, hipStream_t stream) {
    static int grid = 0;
    if (grid == 0) {
        if (n_in != 26 || out_size != NB * SEQ * DM || ws_size < WS_END) { fprintf(stderr, "kernel_launch: unexpected problem (n_in %d, out %d, ws %zu < %zu)\n", n_in, out_size, ws_size, (size_t)WS_END); grid = -1; return; }
        int dev = 0, cus = 0, per_cu = 0;
        hipGetDevice(&dev); hipDeviceGetAttribute(&cus, hipDeviceAttributeMultiprocessorCount, dev);
        if (hipFuncSetAttribute((const void*)fwd_megakernel, hipFuncAttributeMaxDynamicSharedMemorySize, LDS_BYTES) != hipSuccess) { fprintf(stderr, "kernel_launch: hipFuncSetAttribute failed\n"); grid = -1; return; }
        if (hipOccupancyMaxActiveBlocksPerMultiprocessor(&per_cu, (const void*)fwd_megakernel, NTHREADS, LDS_BYTES) != hipSuccess || per_cu < 1) per_cu = 1;
        (void)hipGetLastError();
        grid = cus * per_cu;
    }
    if (grid < 0) return;
    if (hipMemsetAsync((char*)d_ws + OFF_BAR, 0, 16384, stream) != hipSuccess) { fprintf(stderr, "kernel_launch: hipMemsetAsync failed\n"); return; }
    Args a{};
    for (int i = 0; i < 26; ++i) a.in[i] = (const float*)d_in[i];
    a.out = (float*)d_out; a.ws = (unsigned char*)d_ws;
    void* args[] = {&a};
    hipError_t e = hipLaunchCooperativeKernel((const void*)fwd_megakernel, dim3(grid), dim3(NTHREADS), args, LDS_BYTES, stream);
    if (e != hipSuccess) fprintf(stderr, "cooperative launch failed: %s (grid %d)\n", hipGetErrorString(e), grid);
}
```

```cpp
#include <hip/hip_runtime.h>
#include <hip/hip_cooperative_groups.h>
#include <cstdio>
#include <cstdint>
namespace cg = cooperative_groups;
#ifndef PROBE_RW2
#define PROBE_RW2 0
#endif
#ifndef PROBE_SYNC2
#define PROBE_SYNC2 0
#endif
#ifndef PROBE_GEMM2
#define PROBE_GEMM2 0
#endif
#ifndef PROBE_MISC2
#define PROBE_MISC2 0
#endif
#ifndef PROBE_SB2
#define PROBE_SB2 0
#endif
#ifndef PROBE_CV2
#define PROBE_CV2 0
#endif
namespace pg8 {
#define PG8_LAS __attribute__((address_space(3)))
typedef unsigned short bf16_t;
typedef short bf16x8 __attribute__((ext_vector_type(8)));
typedef float f32x4 __attribute__((ext_vector_type(4)));
typedef unsigned u32x4 __attribute__((ext_vector_type(4)));
constexpr int BM = 256, BK = 64, HALF = 128, HTB = HALF * BK * 2  , STAGE_BYTES = 8 * HTB, NXCD = 8, WGM = 8;

__host__ __device__ __forceinline__ int lds_byte(int r, int c) { const int st = (r >> 4) * 2 + (c >> 5), rr = r & 15, cc = c & 31, ob = rr * 64 + cc * 2; return st * 1024 + (ob ^ (((ob >> 9) & 1) << 5)); }
__host__ __device__ __forceinline__ void stage_rc(int b, int& R, int& C) { const int st = b / 1024, sb = b % 1024, swz = sb ^ (((sb >> 9) & 1) << 5); R = (st >> 1) * 16 + swz / 64; C = (st & 1) * 32 + (swz % 64) / 2; }
__host__ __device__ __forceinline__ int perm32(int rho) { const int n = rho >> 4, i = rho & 15; return 8 * (i >> 2) + 4 * n + (i & 3); }

struct Unit { int pm, pn; };
struct Gemm { const bf16_t* A; const bf16_t* Bt; int M, N, K; };

struct StaticOrder {
    int nM, nN, nwg, G, c;
    __host__ __device__ void init(int M, int N, int G_, int c_) { nM = M / BM; nN = N / BM; nwg = nM * nN; G = G_; c = c_; }
    __host__ __device__ bool next(int i, Unit& u) const {
        const long L = (long)i * G + c; if (L >= nwg) return false;
        int wgid = (int)L; { const int q = nwg / NXCD, r = nwg % NXCD, xcd = wgid % NXCD, off = wgid / NXCD; wgid = (xcd < r ? xcd * (q + 1) : r * (q + 1) + (xcd - r) * q) + off; }
        const int nig = WGM * nN, gid = wgid / nig, fm = gid * WGM, gsz = (nM - fm) < WGM ? (nM - fm) : WGM;
        u.pm = fm + ((wgid % nig) % gsz); u.pn = (wgid % nig) / gsz; return true;
    }
    __device__ __forceinline__ void a_ready(const Unit&) const {}
    __device__ __forceinline__ void done(const Unit&) const {}
};

__device__ __forceinline__ unsigned cvt_pk_bf16(float lo, float hi) { unsigned r; asm volatile("v_cvt_pk_bf16_f32 %0, %1, %2" : "=v"(r) : "v"(lo), "v"(hi)); return r; }
template <class Epi, class Sched, bool ALIGN_EPI = false, bool SP2 = false>
__device__ __forceinline__ void gemm_phase(PG8_LAS unsigned char* lds, const Gemm g, const Sched& S, const Epi& E) {
    int tid_ = threadIdx.x; asm volatile("" : "+v"(tid_)); const int tid = tid_, wid = __builtin_amdgcn_readfirstlane(tid >> 6), lane = tid & 63, wr = wid >> 2, wc = wid & 3, fr = lane & 15, fq = lane >> 4;
    const int K = g.K, nt = K / BK;
    unsigned voffA[2], voffB[2];
#pragma unroll
    for (int i = 0; i < 2; ++i) { int R, C; stage_rc(tid * 16 + i * 8192, R, C); const int Rb = Epi::PERM ? ((R & ~31) + perm32(R & 31)) : R;
        voffA[i] = (unsigned)(R * K + C) * 2u; voffB[i] = (unsigned)(Rb * K + C) * 2u; }
    const size_t kstep = (size_t)(BK * 2);
    const size_t hstep = (size_t)HALF * K * 2;
    const size_t tstep = 2 * hstep;
    const unsigned ldsw = (unsigned)wid * 1024u;
    const int aoff = lds_byte(wr * 64 + fr, fq * 8), boff = lds_byte(wc * 32 + fr, fq * 8);
#define PG8_SA(b, h) (((b) * 2 + (h)) * HTB)
#define PG8_SB(b, h) ((4 + (b) * 2 + (h)) * HTB)
#define PG8_STAGE(bufoff, gbase, voff) do { _Pragma("unroll") for (int _i = 0; _i < 2; ++_i) \
        __builtin_amdgcn_global_load_lds((const unsigned*)((const char*)(gbase) + (voff)[_i]), (PG8_LAS unsigned*)(lds + (bufoff) + ldsw + _i * 8192), 16, 0, 0); } while (0)
#define PG8_LDA(dst, b, h) do { _Pragma("unroll") for (int m = 0; m < 4; ++m) _Pragma("unroll") for (int k = 0; k < 2; ++k) dst[m][k] = *(const PG8_LAS bf16x8*)(lds + PG8_SA(b, h) + aoff + m * 2048 + k * 1024); } while (0)
#define PG8_LDB(dst, b, h) do { _Pragma("unroll") for (int n = 0; n < 2; ++n) _Pragma("unroll") for (int k = 0; k < 2; ++k) dst[n][k] = *(const PG8_LAS bf16x8*)(lds + PG8_SB(b, h) + boff + n * 2048 + k * 1024); } while (0)
#define PG8_MMA(ai, bj, At, Bt) do { __builtin_amdgcn_s_setprio(1); _Pragma("unroll") for (int m = 0; m < 4; ++m) _Pragma("unroll") for (int n = 0; n < 2; ++n) _Pragma("unroll") for (int k = 0; k < 2; ++k) \
        acc[ai][bj][m][n] = __builtin_amdgcn_mfma_f32_16x16x32_bf16(Bt[n][k], At[m][k], acc[ai][bj][m][n], 0, 0, 0); __builtin_amdgcn_s_setprio(0); } while (0)
#define PG8_WAIT_V(n) asm volatile("s_waitcnt vmcnt(" #n ")" ::: "memory")
#define PG8_WAIT_L(n) asm volatile("s_waitcnt lgkmcnt(" #n ")" ::: "memory")
#define PG8_BAR __builtin_amdgcn_s_barrier()
#define PG8_SCHED __builtin_amdgcn_sched_barrier(0)
    Unit cur, nxt; int ui = 0;
    if (!S.next(0, cur)) return;
    f32x4 acc[2][2][4][2];
#pragma unroll
    for (int a = 0; a < 2; ++a)
#pragma unroll
        for (int b = 0; b < 2; ++b)
#pragma unroll
            for (int m = 0; m < 4; ++m)
#pragma unroll
                for (int n = 0; n < 2; ++n) acc[a][b][m][n] = (f32x4){0.f, 0.f, 0.f, 0.f};
    bf16x8 At[4][2], B0[2][2], B1[2][2];
    const char* cA = (const char*)g.A + (size_t)cur.pm * tstep; const char* cB = (const char*)g.Bt + (size_t)cur.pn * tstep;
    S.a_ready(cur);
    if constexpr (SP2) {
        PG8_STAGE(PG8_SB(0, 0), cB, voffB); PG8_STAGE(PG8_SB(0, 1), cB + hstep, voffB); PG8_STAGE(PG8_SA(0, 0), cA, voffA); PG8_STAGE(PG8_SA(0, 1), cA + hstep, voffA);
        if (wr == 1) PG8_BAR;
        PG8_WAIT_V(2); PG8_BAR;
        PG8_STAGE(PG8_SB(1, 0), cB + kstep, voffB); PG8_STAGE(PG8_SA(1, 0), cA + kstep, voffA); PG8_STAGE(PG8_SB(1, 1), cB + hstep + kstep, voffB);
        PG8_WAIT_V(6); PG8_BAR;
    } else {
        PG8_STAGE(PG8_SB(0, 0), cB, voffB); PG8_STAGE(PG8_SA(0, 0), cA, voffA); PG8_STAGE(PG8_SB(0, 1), cB + hstep, voffB); PG8_STAGE(PG8_SA(0, 1), cA + hstep, voffA);
        if (wr == 1) PG8_BAR;
        PG8_WAIT_V(4); PG8_BAR;
        PG8_STAGE(PG8_SB(1, 0), cB + kstep, voffB); PG8_STAGE(PG8_SA(1, 0), cA + kstep, voffA); PG8_STAGE(PG8_SB(1, 1), cB + hstep + kstep, voffB);
        PG8_WAIT_V(6); PG8_BAR;
    }
    for (;;) {
        const bool has_next = S.next(ui + 1, nxt);
        const char* nA = has_next ? (const char*)g.A + (size_t)nxt.pm * tstep : cA; const char* nB = has_next ? (const char*)g.Bt + (size_t)nxt.pn * tstep : cB;
        for (int t = 0; t < nt; t += 2) {
            const bool last = (t == nt - 2);
            const char* a1 = cA + (size_t)(t + 1) * kstep;
            const char* a2 = last ? nA : cA + (size_t)(t + 2) * kstep; const char* b2 = last ? nB : cB + (size_t)(t + 2) * kstep;
            const char* a3 = a2 + kstep; const char* b3 = b2 + kstep;
            if (last && has_next) S.a_ready(nxt);
            if constexpr (SP2) {
            PG8_LDB(B0, 0, 0); PG8_LDB(B1, 0, 1); PG8_SCHED; PG8_LDA(At, 0, 0); PG8_STAGE(PG8_SA(1, 1), a1 + hstep, voffA);
            PG8_WAIT_V(8); PG8_WAIT_L(0); PG8_BAR; PG8_MMA(0, 0, At, B0); PG8_MMA(0, 1, At, B1); PG8_BAR; PG8_SCHED;
            PG8_LDA(At, 0, 1); PG8_STAGE(PG8_SB(0, 0), b2, voffB); PG8_STAGE(PG8_SB(0, 1), b2 + hstep, voffB); PG8_STAGE(PG8_SA(0, 0), a2, voffA);
            PG8_WAIT_V(8); PG8_WAIT_L(0); PG8_BAR; PG8_MMA(1, 0, At, B0); PG8_MMA(1, 1, At, B1); PG8_BAR; PG8_SCHED;
            PG8_LDB(B0, 1, 0); PG8_LDB(B1, 1, 1); PG8_SCHED; PG8_LDA(At, 1, 0); PG8_STAGE(PG8_SA(0, 1), a2 + hstep, voffA);
            PG8_WAIT_V(8); PG8_WAIT_L(0); PG8_BAR; PG8_MMA(0, 0, At, B0); PG8_MMA(0, 1, At, B1); PG8_BAR; PG8_SCHED;
            PG8_LDA(At, 1, 1); PG8_STAGE(PG8_SB(1, 0), b3, voffB); PG8_STAGE(PG8_SB(1, 1), b3 + hstep, voffB); PG8_STAGE(PG8_SA(1, 0), a3, voffA);
            PG8_WAIT_V(8); PG8_WAIT_L(0); PG8_BAR; PG8_MMA(1, 0, At, B0); PG8_MMA(1, 1, At, B1); PG8_BAR; PG8_SCHED;
            } else {
            PG8_LDB(B0, 0, 0); PG8_SCHED; PG8_LDA(At, 0, 0); PG8_STAGE(PG8_SA(1, 1), a1 + hstep, voffA);
            PG8_WAIT_L(8); PG8_BAR; PG8_WAIT_L(0); PG8_MMA(0, 0, At, B0); PG8_BAR; PG8_SCHED;
            PG8_LDB(B1, 0, 1); PG8_STAGE(PG8_SB(0, 0), b2, voffB);
            PG8_BAR; PG8_WAIT_L(0); PG8_MMA(0, 1, At, B1); PG8_BAR;
            PG8_LDA(At, 0, 1); PG8_STAGE(PG8_SA(0, 0), a2, voffA);
            PG8_BAR; PG8_WAIT_L(0); PG8_MMA(1, 0, At, B0); PG8_BAR; PG8_SCHED;
            PG8_STAGE(PG8_SB(0, 1), b2 + hstep, voffB);
            PG8_WAIT_V(6); PG8_BAR; PG8_MMA(1, 1, At, B1); PG8_BAR;
            PG8_LDB(B0, 1, 0); PG8_SCHED; PG8_LDA(At, 1, 0); PG8_STAGE(PG8_SA(0, 1), a2 + hstep, voffA);
            PG8_WAIT_L(8); PG8_BAR; PG8_WAIT_L(0); PG8_MMA(0, 0, At, B0); PG8_BAR; PG8_SCHED;
            PG8_LDB(B1, 1, 1); PG8_STAGE(PG8_SB(1, 0), b3, voffB);
            PG8_BAR; PG8_WAIT_L(0); PG8_MMA(0, 1, At, B1); PG8_BAR;
            PG8_LDA(At, 1, 1); PG8_STAGE(PG8_SA(1, 0), a3, voffA);
            PG8_BAR; PG8_WAIT_L(0); PG8_MMA(1, 0, At, B0); PG8_BAR; PG8_SCHED;
            PG8_STAGE(PG8_SB(1, 1), b3 + hstep, voffB);
            PG8_WAIT_V(6); PG8_BAR; PG8_MMA(1, 1, At, B1); PG8_BAR;
            }
        }
        if constexpr (ALIGN_EPI) { if (wr == 0) PG8_BAR; }
        if constexpr (!Epi::AFTER_DRAIN) { E(acc, cur, wr, wc, fr, fq); S.done(cur); }
        if (!has_next) break;
#pragma unroll
        for (int a = 0; a < 2; ++a)
#pragma unroll
            for (int b = 0; b < 2; ++b)
#pragma unroll
                for (int m = 0; m < 4; ++m)
#pragma unroll
                    for (int n = 0; n < 2; ++n) acc[a][b][m][n] = (f32x4){0.f, 0.f, 0.f, 0.f};
        cur = nxt; cA = nA; cB = nB; ++ui;
        if constexpr (ALIGN_EPI) { if (wr == 1) PG8_BAR; }
    }
    PG8_WAIT_V(0);
    if constexpr (!ALIGN_EPI) { if (wr == 0) PG8_BAR; }
    PG8_BAR;
    if constexpr (Epi::AFTER_DRAIN) { E.fused(acc, cur, wr, wc, fr, fq, lds, wid, lane); S.done(cur); }
#undef PG8_SA
#undef PG8_SB
#undef PG8_STAGE
#undef PG8_LDA
#undef PG8_LDB
#undef PG8_MMA
#undef PG8_WAIT_V
#undef PG8_WAIT_L
#undef PG8_BAR
#undef PG8_SCHED
}
}
constexpr int DM = 1024, NB = 4, SEQ = 4096, NMETA = 16, LT = SEQ + NMETA  , T = NB * LT  , MP = 16640  , DEPTH = 4;
constexpr int RWCOLS = 1824, INCOLS = 5408, FFH = 2816, NH = 8;
constexpr float RMS_EPS = 1e-6f, GN_EPS = 64e-5f;
constexpr float C2 = 0.125f * 1.4426950408889634f;
constexpr int NWAVES = 8, NTHREADS = 512;

#define LAS __attribute__((address_space(3)))
typedef unsigned short bf16_t;
typedef short bf16x8 __attribute__((ext_vector_type(8)));
typedef short s16x4 __attribute__((ext_vector_type(4)));
typedef float f32x4 __attribute__((ext_vector_type(4)));
typedef float f32x16 __attribute__((ext_vector_type(16)));
typedef unsigned u32x4 __attribute__((ext_vector_type(4)));
typedef unsigned u32x2 __attribute__((ext_vector_type(2)));
typedef float f32x2_t __attribute__((ext_vector_type(2))); typedef __bf16 bf16x2_t __attribute__((ext_vector_type(2)));
__device__ __forceinline__ unsigned cvt_pk_bf16(float lo, float hi) { f32x2_t v = {lo, hi}; bf16x2_t b = __builtin_convertvector(v, bf16x2_t); return __builtin_bit_cast(unsigned, b); }

constexpr size_t al256(size_t x) { return (x + 255) & ~(size_t)255; }
constexpr size_t OFF_SSQ = 0;
constexpr size_t OFF_BONUS = al256(OFF_SSQ + (size_t)2 * MP * 16 * 4);
constexpr size_t OFF_W1A = al256(OFF_BONUS + (size_t)T * 8 * 4);
constexpr size_t OFF_WV = OFF_W1A + (size_t)3072 * 1024 * 2;
constexpr size_t OFF_WG = OFF_WV + (size_t)512 * 1024 * 2;
constexpr size_t OFF_WL = OFF_WG + (size_t)2048 * 1024 * 2;
constexpr size_t OFF_WSB = OFF_WL + (size_t)2048 * 384 * 2;
constexpr size_t OFF_WRW = OFF_WSB + (size_t)1024 * 512 * 2;
constexpr size_t OFF_WO = OFF_WRW + (size_t)1024 * 512 * 2;
constexpr size_t OFF_H = OFF_WO + (size_t)1024 * 1024 * 2;
constexpr size_t OFF_HB = OFF_H + (size_t)MP * 1024 * 4;
constexpr size_t OFF_VFIRST = OFF_HB + (size_t)MP * 1024 * 2;
constexpr size_t OFF_E = al256(OFF_VFIRST + (size_t)T * 512 * 2);
constexpr size_t OFF_F = OFF_E + (size_t)MP * 2048 * 2;
constexpr size_t OFF_G = OFF_F + (size_t)MP * 2048 * 2;
constexpr size_t OFF_WF1 = OFF_H;
constexpr size_t OFF_WF2 = OFF_WF1 + (size_t)5632 * 1024 * 2;
constexpr size_t OFF_HH = OFF_G + (size_t)MP * 1024 * 2;
constexpr size_t OFF_I = OFF_HH + (size_t)512 * MP * 2;
constexpr size_t OFF_J = OFF_I + (size_t)MP * 512 * 2;
constexpr size_t OFF_BAR = al256(OFF_J + (size_t)MP * 512 * 2);
constexpr size_t WS_END = OFF_BAR + 16384;
static_assert(WS_END <= (size_t)369098752, "workspace map exceeds 4x the largest input tensor");
static_assert((size_t)MP * 2816 * 2 <= 2 * (size_t)MP * 2048 * 2, "HID fits E+F");

constexpr int LDS_BYTES = 147456;

__device__ __forceinline__ float bf2f(bf16_t v) { return __uint_as_float((unsigned)v << 16); }
__device__ __forceinline__ float bflo(unsigned w) { return __uint_as_float(w << 16); }
__device__ __forceinline__ float bfhi(unsigned w) { return __uint_as_float(w & 0xffff0000u); }
__device__ __forceinline__ bf16_t f2bf(float f) { return (bf16_t)(cvt_pk_bf16(f, 0.f) & 0xffffu); }
__device__ __forceinline__ int opq(int v) { asm volatile("" : "+v"(v)); return v; }
template <int CTRL, int ROWMASK> __device__ __forceinline__ float dpp0(float v) { return __builtin_bit_cast(float, __builtin_amdgcn_update_dpp(0, __builtin_bit_cast(int, v), CTRL, ROWMASK, 0xF, false)); }
__device__ __forceinline__ float wave_sum(float v) {
    v += dpp0<0xB1, 0xF>(v);
    v += dpp0<0x4E, 0xF>(v);
    v += dpp0<0x141, 0xF>(v);
    v += dpp0<0x140, 0xF>(v);
    v += dpp0<0x142, 0xA>(v);
    v += dpp0<0x143, 0xC>(v);
    return __builtin_bit_cast(float, __builtin_amdgcn_readlane(__builtin_bit_cast(int, v), 63));
}
__device__ __forceinline__ void wave_sum2(float& a, float& b) {
    a += dpp0<0xB1, 0xF>(a); b += dpp0<0xB1, 0xF>(b); a += dpp0<0x4E, 0xF>(a); b += dpp0<0x4E, 0xF>(b);
    a += dpp0<0x141, 0xF>(a); b += dpp0<0x141, 0xF>(b); a += dpp0<0x140, 0xF>(a); b += dpp0<0x140, 0xF>(b);
    a += dpp0<0x142, 0xA>(a); b += dpp0<0x142, 0xA>(b); a += dpp0<0x143, 0xC>(a); b += dpp0<0x143, 0xC>(b);
    a = __builtin_bit_cast(float, __builtin_amdgcn_readlane(__builtin_bit_cast(int, a), 63)); b = __builtin_bit_cast(float, __builtin_amdgcn_readlane(__builtin_bit_cast(int, b), 63));
}
__device__ __forceinline__ float row_rstd(const float* part, int row) {
    const f32x4* p = (const f32x4*)(part + (size_t)row * 16);
    const f32x4 a = p[0], b = p[1], c = p[2], d = p[3];
    const float s = ((a[0] + a[1]) + (a[2] + a[3])) + ((b[0] + b[1]) + (b[2] + b[3])) + (((c[0] + c[1]) + (c[2] + c[3])) + ((d[0] + d[1]) + (d[2] + d[3])));
    return rsqrtf(s * (1.f / 1024.f) + RMS_EPS);
}
__device__ __forceinline__ float fexp(float x) { return __builtin_amdgcn_exp2f(1.4426950408889634f * x); }
__device__ __forceinline__ float fsigmoid(float x) { return __builtin_amdgcn_rcpf(1.f + __builtin_amdgcn_exp2f(-1.4426950408889634f * x)); }
__device__ __forceinline__ float fsoftplus(float x) { return fmaxf(x, 0.f) + 0.6931471805599453f * __builtin_amdgcn_logf(1.f + __builtin_amdgcn_exp2f(-1.4426950408889634f * fabsf(x))); }

template <int ACT, bool HAS_SSQ> struct EpiStore {
    static constexpr bool PERM = true, AFTER_DRAIN = false;
    bf16_t* O0; int ld0; bf16_t* O1; int ld1; int split; const float* ssq; float scale0; int n0;
    __device__ __forceinline__ void operator()(const f32x4 (&acc)[2][2][4][2], const pg8::Unit& u, int wr, int wc, int fr, int fq) const {
        bf16_t* base; int ld, colt;
        if (u.pn < split) { base = O0; ld = ld0; colt = u.pn * 256; } else { base = O1; ld = ld1; colt = (u.pn - split) * 256; }
        const float sc = (u.pn < n0) ? scale0 : 1.f;
        const int row0 = u.pm * 256 + wr * 64 + fr;
        unsigned off = (unsigned)row0 * (unsigned)ld + (unsigned)(colt + wc * 32 + 8 * fq);
#pragma unroll
        for (int ai = 0; ai < 2; ++ai) {
#pragma unroll
            for (int m = 0; m < 4; ++m) {
                float rs = sc; if (HAS_SSQ) rs *= row_rstd(ssq, row0 + ai * 128 + m * 16);
#pragma unroll
                for (int bj = 0; bj < 2; ++bj) {
                    f32x4 v0 = acc[ai][bj][m][0] * rs, v1 = acc[ai][bj][m][1] * rs;
                    if (ACT) {
#pragma unroll
                        for (int e = 0; e < 4; ++e) { v0[e] = fsigmoid(v0[e]); v1[e] = fsigmoid(v1[e]); }
                    }
                    u32x4 w; w.x = cvt_pk_bf16(v0[0], v0[1]); w.y = cvt_pk_bf16(v0[2], v0[3]); w.z = cvt_pk_bf16(v1[0], v1[1]); w.w = cvt_pk_bf16(v1[2], v1[3]);
                    *(u32x4*)(base + off + bj * 128) = w;
                }
                off += 16u * (unsigned)ld;
                asm volatile("" ::: "memory");
            }
            off += 64u * (unsigned)ld;
        }
    }
};
struct EpiVT {
    static constexpr bool PERM = true, AFTER_DRAIN = false;
    bf16_t* O; int ld; const float* ssq;
    __device__ __forceinline__ void operator()(const f32x4 (&acc)[2][2][4][2], const pg8::Unit& u, int wr, int wc, int fr, int fq) const {
        const int row0 = u.pm * 256 + wr * 64 + fr, col0 = u.pn * 256 + wc * 32 + 8 * fq;
        f32x4 rs[2][2];
#pragma unroll
        for (int bj = 0; bj < 2; ++bj)
#pragma unroll
            for (int n = 0; n < 2; ++n)
#pragma unroll
                for (int e = 0; e < 4; ++e) rs[bj][n][e] = row_rstd(ssq, col0 + bj * 128 + 4 * n + e);
#pragma unroll
        for (int ai = 0; ai < 2; ++ai)
#pragma unroll
            for (int m = 0; m < 4; ++m) {
                bf16_t* rowp = O + (size_t)(row0 + ai * 128 + m * 16) * ld + col0;
#pragma unroll
                for (int bj = 0; bj < 2; ++bj) {
                    const f32x4 v0 = acc[ai][bj][m][0] * rs[bj][0], v1 = acc[ai][bj][m][1] * rs[bj][1];
                    u32x4 w; w.x = cvt_pk_bf16(v0[0], v0[1]); w.y = cvt_pk_bf16(v0[2], v0[3]); w.z = cvt_pk_bf16(v1[0], v1[1]); w.w = cvt_pk_bf16(v1[2], v1[3]);
                    *(u32x4*)(rowp + bj * 128) = w;
                }
            }
    }
};
struct EpiGateMul {
    static constexpr bool PERM = true, AFTER_DRAIN = false;
    bf16_t* O; const bf16_t* gate; int ldg; int gcol; int accum;
    __device__ __forceinline__ void operator()(const f32x4 (&acc)[2][2][4][2], const pg8::Unit& u, int wr, int wc, int fr, int fq) const {
        const int row0 = u.pm * 256 + wr * 64 + fr, col0 = u.pn * 256 + wc * 32 + 8 * fq;
#pragma unroll
        for (int ai = 0; ai < 2; ++ai)
#pragma unroll
            for (int m = 0; m < 4; ++m) {
                const int row = row0 + ai * 128 + m * 16;
#pragma unroll
                for (int bj = 0; bj < 2; ++bj) {
                    const int col = col0 + bj * 128;
                    const u32x4 g = *(const u32x4*)(gate + (size_t)row * ldg + gcol + col);
                    bf16_t* op = O + (size_t)row * 1024 + col;
                    u32x4 p = (u32x4){0u, 0u, 0u, 0u}; if (accum) p = *(const u32x4*)op;
                    const f32x4 a0 = acc[ai][bj][m][0], a1 = acc[ai][bj][m][1];
                    u32x4 w;
                    w.x = cvt_pk_bf16(bflo(g.x) * a0[0] + bflo(p.x), bfhi(g.x) * a0[1] + bfhi(p.x));
                    w.y = cvt_pk_bf16(bflo(g.y) * a0[2] + bflo(p.y), bfhi(g.y) * a0[3] + bfhi(p.y));
                    w.z = cvt_pk_bf16(bflo(g.z) * a1[0] + bflo(p.z), bfhi(g.z) * a1[1] + bfhi(p.z));
                    w.w = cvt_pk_bf16(bflo(g.w) * a1[2] + bflo(p.w), bfhi(g.w) * a1[3] + bfhi(p.w));
                    *(u32x4*)op = w;
                }
            }
    }
};
struct EpiResid {
    static constexpr bool PERM = true, AFTER_DRAIN = false;
    bf16_t* HB; float* ssq_next;
    __device__ __forceinline__ void operator()(const f32x4 (&acc)[2][2][4][2], const pg8::Unit& u, int wr, int wc, int fr, int fq) const {
        const int row0 = u.pm * 256 + wr * 64 + fr, col0 = u.pn * 256 + wc * 32 + 8 * fq;
#pragma unroll
        for (int ai = 0; ai < 2; ++ai)
#pragma unroll
            for (int m = 0; m < 4; ++m) {
                const int row = row0 + ai * 128 + m * 16; float ss = 0.f;
#pragma unroll
                for (int bj = 0; bj < 2; ++bj) {
                    bf16_t* hp = HB + (size_t)row * 1024 + col0 + bj * 128;
                    const u32x4 hb = *(const u32x4*)hp;
                    f32x4 h0 = (f32x4){bflo(hb.x), bfhi(hb.x), bflo(hb.y), bfhi(hb.y)}, h1 = (f32x4){bflo(hb.z), bfhi(hb.z), bflo(hb.w), bfhi(hb.w)};
                    h0 += acc[ai][bj][m][0]; h1 += acc[ai][bj][m][1];
                    u32x4 w; w.x = cvt_pk_bf16(h0[0], h0[1]); w.y = cvt_pk_bf16(h0[2], h0[3]); w.z = cvt_pk_bf16(h1[0], h1[1]); w.w = cvt_pk_bf16(h1[2], h1[3]);
                    *(u32x4*)hp = w;
                    ss += (h0[0] * h0[0] + h0[1] * h0[1]) + (h0[2] * h0[2] + h0[3] * h0[3]) + (h1[0] * h1[0] + h1[1] * h1[1]) + (h1[2] * h1[2] + h1[3] * h1[3]);
                }
                ss += __shfl_xor(ss, 16); ss += __shfl_xor(ss, 32);
                if (fq == 0) ssq_next[(size_t)row * 16 + u.pn * 4 + wc] = ss;
            }
    }
};
struct EpiSwiglu {
    static constexpr bool PERM = true, AFTER_DRAIN = false;
    bf16_t* O; const float* ssq;
    __device__ __forceinline__ void operator()(const f32x4 (&acc)[2][2][4][2], const pg8::Unit& u, int wr, int wc, int fr, int fq) const {
        const int row0 = u.pm * 256 + wr * 64 + fr, hcol0 = u.pn * 128 + wc * 16 + 4 * fq;
#pragma unroll
        for (int ai = 0; ai < 2; ++ai)
#pragma unroll
            for (int m = 0; m < 4; ++m) {
                const int row = row0 + ai * 128 + m * 16;
                const float rs = row_rstd(ssq, row);
#pragma unroll
                for (int bj = 0; bj < 2; ++bj) {
                    const f32x4 g = acc[ai][bj][m][0] * rs, up = acc[ai][bj][m][1] * rs;
                    float hv[4];
#pragma unroll
                    for (int e = 0; e < 4; ++e) hv[e] = g[e] * fsigmoid(g[e]) * up[e];
                    u32x2 w; w.x = cvt_pk_bf16(hv[0], hv[1]); w.y = cvt_pk_bf16(hv[2], hv[3]);
                    *(u32x2*)(O + (size_t)row * FFH + hcol0 + bj * 64) = w;
                }
            }
    }
};


constexpr int MB = 16384;
struct TStoreP { bf16_t* O0; int ld0; bf16_t* O1; int ld1; int split_col; const float* ssq; float scale0; int n0_col; };
template <int ACT, bool HAS_SSQ> struct TStore { TStoreP p;
    __device__ __forceinline__ void operator()(int row, int col0, const float (&v)[8], int) const {
        bf16_t* base; int ld, col;
        if (col0 < p.split_col) { base = p.O0; ld = p.ld0; col = col0; } else { base = p.O1; ld = p.ld1; col = col0 - p.split_col; }
        float rs = (col0 < p.n0_col) ? p.scale0 : 1.f; if (HAS_SSQ) rs *= row_rstd(p.ssq, row);
        float o[8];
#pragma unroll
        for (int e = 0; e < 8; ++e) { o[e] = v[e] * rs; if (ACT) o[e] = fsigmoid(o[e]); }
        u32x4 w; w.x = cvt_pk_bf16(o[0], o[1]); w.y = cvt_pk_bf16(o[2], o[3]); w.z = cvt_pk_bf16(o[4], o[5]); w.w = cvt_pk_bf16(o[6], o[7]);
        *(u32x4*)(base + (size_t)row * ld + col) = w;
    } };
struct TVT { bf16_t* O; int ld; const float* ssq;
    __device__ __forceinline__ void operator()(int row, int col0, const float (&v)[8], int) const {
        const float rs = row_rstd(ssq, row);
#pragma unroll
        for (int e = 0; e < 8; ++e) O[(size_t)(col0 + e) * ld + row] = f2bf(v[e] * rs);
    } };
struct TGateMul { bf16_t* O; const bf16_t* gate; int ldg; int gcol; int accum;
    __device__ __forceinline__ void operator()(int row, int col0, const float (&v)[8], int) const {
        const u32x4 g = *(const u32x4*)(gate + (size_t)row * ldg + gcol + col0); bf16_t* op = O + (size_t)row * 1024 + col0;
        u32x4 p = (u32x4){0u, 0u, 0u, 0u}; if (accum) p = *(const u32x4*)op;
        u32x4 w;
        w.x = cvt_pk_bf16(bflo(g.x) * v[0] + bflo(p.x), bfhi(g.x) * v[1] + bfhi(p.x)); w.y = cvt_pk_bf16(bflo(g.y) * v[2] + bflo(p.y), bfhi(g.y) * v[3] + bfhi(p.y));
        w.z = cvt_pk_bf16(bflo(g.z) * v[4] + bflo(p.z), bfhi(g.z) * v[5] + bfhi(p.z)); w.w = cvt_pk_bf16(bflo(g.w) * v[6] + bflo(p.w), bfhi(g.w) * v[7] + bfhi(p.w));
        *(u32x4*)op = w;
    } };
struct TResid { bf16_t* HB; float* ssq_next;
    __device__ __forceinline__ void operator()(int row, int col0, const float (&v)[8], int unit) const {
        bf16_t* hp = HB + (size_t)row * 1024 + col0; const u32x4 hb = *(const u32x4*)hp;
        f32x4 h0 = (f32x4){bflo(hb.x), bfhi(hb.x), bflo(hb.y), bfhi(hb.y)}, h1 = (f32x4){bflo(hb.z), bfhi(hb.z), bflo(hb.w), bfhi(hb.w)};
        h0 += (f32x4){v[0], v[1], v[2], v[3]}; h1 += (f32x4){v[4], v[5], v[6], v[7]};
        u32x4 w; w.x = cvt_pk_bf16(h0[0], h0[1]); w.y = cvt_pk_bf16(h0[2], h0[3]); w.z = cvt_pk_bf16(h1[0], h1[1]); w.w = cvt_pk_bf16(h1[2], h1[3]);
        *(u32x4*)hp = w;
        float ss = (h0[0] * h0[0] + h0[1] * h0[1]) + (h0[2] * h0[2] + h0[3] * h0[3]) + (h1[0] * h1[0] + h1[1] * h1[1]) + (h1[2] * h1[2] + h1[3] * h1[3]);
        ss += __shfl_xor(ss, 1); ss += __shfl_xor(ss, 2); ss += __shfl_xor(ss, 4);
        if ((col0 & 63) == 0) ssq_next[(size_t)row * 16 + unit] = ss;
    } };
struct TSwiglu { bf16_t* O; const float* ssq;
    __device__ __forceinline__ void operator()(int row, int col0, const float (&v)[8], int) const {
        const float rs = row_rstd(ssq, row); float hv[4];
#pragma unroll
        for (int e = 0; e < 4; ++e) { const float g = v[e] * rs, up = v[4 + e] * rs; hv[e] = g * fsigmoid(g) * up; }
        u32x2 w; w.x = cvt_pk_bf16(hv[0], hv[1]); w.y = cvt_pk_bf16(hv[2], hv[3]);
        *(u32x2*)(O + (size_t)row * FFH + (col0 >> 1)) = w;
    } };
template <class TE> __device__ __forceinline__ void tail_gemm(LAS unsigned char* lds, const bf16_t* A, const bf16_t* Bt, int K, int N, const TE& E, int wave, int lane, int boff = 0) {
    const int r32 = lane & 31, hi = lane >> 5, kw = K >> 3, k0 = wave * kw, tid = opq((int)threadIdx.x);
    if (boff >= (int)gridDim.x) boff = 0;
    LAS float* P = (LAS float*)lds;
    for (int unit = (int)blockIdx.x >= boff ? (int)blockIdx.x - boff : (int)blockIdx.x + (int)gridDim.x - boff; unit < (N >> 6); unit += gridDim.x) {
        f32x16 acc[2][2];
#pragma unroll
        for (int i = 0; i < 2; ++i)
#pragma unroll
            for (int j = 0; j < 2; ++j)
#pragma unroll
                for (int r = 0; r < 16; ++r) acc[i][j][r] = 0.f;
        const bf16_t* ap = A + (size_t)r32 * K + k0 + hi * 8;
        const bf16_t* bp = Bt + (size_t)(unit * 64 + r32) * K + k0 + hi * 8;
#pragma unroll 4
        for (int ks = 0; ks < kw; ks += 16) {
            const bf16x8 a0 = *(const bf16x8*)(ap + ks), a1 = *(const bf16x8*)(ap + (size_t)32 * K + ks), b0 = *(const bf16x8*)(bp + ks), b1 = *(const bf16x8*)(bp + (size_t)32 * K + ks);
            acc[0][0] = __builtin_amdgcn_mfma_f32_32x32x16_bf16(a0, b0, acc[0][0], 0, 0, 0); acc[0][1] = __builtin_amdgcn_mfma_f32_32x32x16_bf16(a0, b1, acc[0][1], 0, 0, 0);
            acc[1][0] = __builtin_amdgcn_mfma_f32_32x32x16_bf16(a1, b0, acc[1][0], 0, 0, 0); acc[1][1] = __builtin_amdgcn_mfma_f32_32x32x16_bf16(a1, b1, acc[1][1], 0, 0, 0);
        }
#pragma unroll
        for (int i = 0; i < 2; ++i)
#pragma unroll
            for (int j = 0; j < 2; ++j)
#pragma unroll
                for (int r = 0; r < 16; ++r) P[(wave * 64 + 32 * i + (r & 3) + 8 * (r >> 2) + 4 * hi) * 64 + 32 * j + r32] = acc[i][j][r];
        __syncthreads();
        const int row = tid >> 3, cgp = tid & 7; float v[8];
#pragma unroll
        for (int e = 0; e < 8; ++e) v[e] = 0.f;
#pragma unroll
        for (int w = 0; w < 8; ++w) { const f32x4 p0 = *(const LAS f32x4*)(P + (w * 64 + row) * 64 + cgp * 8), p1 = *(const LAS f32x4*)(P + (w * 64 + row) * 64 + cgp * 8 + 4);
            v[0] += p0[0]; v[1] += p0[1]; v[2] += p0[2]; v[3] += p0[3]; v[4] += p1[0]; v[5] += p1[1]; v[6] += p1[2]; v[7] += p1[3]; }
        E(MB + row, unit * 64 + cgp * 8, v, unit);
        __syncthreads();
    }
}

struct Args { const float* in[26]; float* out; unsigned char* ws; };
typedef const __attribute__((address_space(4))) Args* CArgs;
__device__ __forceinline__ CArgs opq_args(CArgs p) { asm volatile("" : "+s"(p)); return p; }
enum { I_X = 0, I_META, I_NMIX, I_NFFN, I_NFIN, I_WIN, I_MURW, I_W0, I_WUP, I_A0, I_AUP, I_GUP, I_KK, I_KA, I_RK, I_LNW, I_LNB, I_VDOWN, I_VMU, I_VUP, I_VRES0, I_WSB, I_WRW, I_WOUT, I_WF1, I_WF2 };

__device__ __forceinline__ void tr_item(const float* W, int ldw, int c0, int nblk, int item, bf16_t* D, int ldd, int r0, int mode, const float* gain, LAS float* scr, int lane) {
    const int kb = item / nblk, nb = item % nblk, k0 = 64 * kb, n0 = 32 * nb;
    float tv[32];
#pragma unroll
    for (int i = 0; i < 32; ++i) tv[i] = W[(size_t)(k0 + 2 * i + (lane >> 5)) * ldw + c0 + n0 + (lane & 31)];
#pragma unroll
    for (int i = 0; i < 32; ++i) { const int kk = 2 * i + (lane >> 5); float v = tv[i]; if (gain) v *= gain[k0 + kk]; scr[kk * 33 + (lane & 31)] = v; }
    asm volatile("s_waitcnt lgkmcnt(0)" ::: "memory");
    const int c = lane & 7;
#pragma unroll
    for (int j = 0; j < 4; ++j) {
        const int n = (lane >> 3) + 8 * j; const LAS float* s = scr + (8 * c) * 33 + n;
        u32x4 o; o.x = cvt_pk_bf16(s[0 * 33], s[1 * 33]); o.y = cvt_pk_bf16(s[2 * 33], s[3 * 33]); o.z = cvt_pk_bf16(s[4 * 33], s[5 * 33]); o.w = cvt_pk_bf16(s[6 * 33], s[7 * 33]);
        int drow;
        if (mode == 0) drow = r0 + n0 + n;
        else { const int col = c0 + n0 + n, isup = col >= FFH ? 1 : 0, jj = col - isup * FFH; drow = 8 * (jj >> 2) + 4 * isup + (jj & 3); }
        *(u32x4*)(D + (size_t)drow * ldd + k0 + 8 * c) = o;
    }
    asm volatile("s_waitcnt lgkmcnt(0)" ::: "memory");
}
__device__ __forceinline__ void tr_job(const float* W, int K, int ldw, int c0, int ncols, bf16_t* D, int ldd, int r0, int mode, const float* gain, LAS float* scr, int lane, int gw, int ngw) {
    const int nblk = ncols / 32, nitems = (K / 64) * nblk;
    for (int it = gw; it < nitems; it += ngw) tr_item(W, ldw, c0, nblk, it, D, ldd, r0, mode, gain, scr, lane);
}
__device__ __forceinline__ void zero16(void* p, size_t bytes, int gtid, int ngt) {
    u32x4* q = (u32x4*)p; const size_t n = bytes / 16;
    for (size_t i = gtid; i < n; i += ngt) q[i] = (u32x4){0u, 0u, 0u, 0u};
}
__device__ __forceinline__ void convert_mix_weights(CArgs a, int l, LAS unsigned char* lds, int wave, int lane, int gw, int ngw) {
    unsigned char* ws = a->ws;
    LAS float* scr = (LAS float*)(lds + wave * 8448);
    const float* win = a->in[I_WIN] + (size_t)l * DM * INCOLS; const float* gmix = a->in[I_NMIX] + l * DM;
    bf16_t* W1A = (bf16_t*)(ws + OFF_W1A);
    tr_job(win, DM, INCOLS, 0, 1024, W1A, 1024, 0, 0, gmix, scr, lane, gw, ngw);
    tr_job(win, DM, INCOLS, 1536, RWCOLS, W1A, 1024, 1024, 0, gmix, scr, lane, gw, ngw);
    const int gtid = gw * 64 + lane, ngt = ngw * 64;
    if (l > 0) { tr_job(a->in[I_VDOWN] + (size_t)(l - 1) * DM * 32, DM, 32, 0, 32, W1A, 1024, 1024 + RWCOLS, 0, gmix, scr, lane, gw, ngw);
                 zero16(W1A + (size_t)(1024 + RWCOLS + 32) * 1024, (size_t)(3072 - 1024 - RWCOLS - 32) * 1024 * 2, gtid, ngt); }
    else zero16(W1A + (size_t)(1024 + RWCOLS) * 1024, (size_t)(3072 - 1024 - RWCOLS) * 1024 * 2, gtid, ngt);
    tr_job(win, DM, INCOLS, 1024, 512, (bf16_t*)(ws + OFF_WV), 1024, 0, 0, gmix, scr, lane, gw, ngw);
    tr_job(win, DM, INCOLS, 3360, 2048, (bf16_t*)(ws + OFF_WG), 1024, 0, 0, gmix, scr, lane, gw, ngw);
    tr_job(a->in[I_WSB] + (size_t)l * 512 * 1024, 512, 1024, 0, 1024, (bf16_t*)(ws + OFF_WSB), 512, 0, 0, nullptr, scr, lane, gw, ngw);
    tr_job(a->in[I_WRW] + (size_t)l * 512 * 1024, 512, 1024, 0, 1024, (bf16_t*)(ws + OFF_WRW), 512, 0, 0, nullptr, scr, lane, gw, ngw);
    tr_job(a->in[I_WOUT] + (size_t)l * 1024 * 1024, 1024, 1024, 0, 1024, (bf16_t*)(ws + OFF_WO), 1024, 0, 0, nullptr, scr, lane, gw, ngw);
    bf16_t* WL = (bf16_t*)(ws + OFF_WL);
    const float* wup = a->in[I_WUP] + (size_t)l * 64 * 512; const float* aup = a->in[I_AUP] + (size_t)l * 64 * 512; const float* gup = a->in[I_GUP] + (size_t)l * 160 * 512;
    const float* vup = a->in[I_VUP] + (size_t)(l > 0 ? l - 1 : 0) * 32 * 512;
    for (int idx = gtid; idx < 2048 * 384; idx += ngt) {
        const int n = idx / 384, k = idx - n * 384, grp = n >> 9, cn = n & 511; float v = 0.f;
        if (grp == 0) { if (k < 64) v = wup[k * 512 + cn]; }
        else if (grp == 1) { if (k >= 64 && k < 128) v = aup[(k - 64) * 512 + cn]; }
        else if (grp == 2) { if (k >= 128 && k < 288) v = gup[(k - 128) * 512 + cn]; }
        else { if (l > 0 && k >= 288 && k < 320) v = vup[(k - 288) * 512 + cn]; }
        WL[idx] = f2bf(v);
    }
}
__device__ __forceinline__ void convert_ffn_weights(CArgs a, int l, LAS unsigned char* lds, int wave, int lane, int gw, int ngw) {
    LAS float* scr = (LAS float*)(lds + wave * 8448);
    tr_job(a->in[I_WF1] + (size_t)l * DM * 2 * FFH, DM, 2 * FFH, 0, 2 * FFH, (bf16_t*)(a->ws + OFF_WF1), 1024, 0, 1, a->in[I_NFFN] + l * DM, scr, lane, gw, ngw);
    tr_job(a->in[I_WF2] + (size_t)l * FFH * DM, FFH, DM, 0, DM, (bf16_t*)(a->ws + OFF_WF2), FFH, 0, 0, nullptr, scr, lane, gw, ngw);
}

__device__ __forceinline__ void init_rows(CArgs a, int lane, int gw, int ngw) {
    bf16_t* HB = (bf16_t*)(a->ws + OFF_HB); float* ssq = (float*)(a->ws + OFF_SSQ);
    for (int row0 = gw; row0 < MP; row0 += 4 * ngw) {
        f32x4 v[4][4]; float s[4];
#pragma unroll
        for (int k = 0; k < 4; ++k) { const int row = row0 + k * ngw; s[k] = 0.f;
            if (row < T) { const int b = row / LT, t = row - b * LT;
                const float* src = t < NMETA ? a->in[I_META] + (size_t)t * DM : a->in[I_X] + ((size_t)b * SEQ + (t - NMETA)) * DM;
#pragma unroll
                for (int j = 0; j < 4; ++j) v[k][j] = *((const f32x4*)src + lane + 64 * j);
            } else {
#pragma unroll
                for (int j = 0; j < 4; ++j) v[k][j] = (f32x4){0.f, 0.f, 0.f, 0.f};
            } }
#pragma unroll
        for (int k = 0; k < 4; ++k) { const int row = row0 + k * ngw;
            if (row < MP) {
#pragma unroll
                for (int j = 0; j < 4; ++j) s[k] += (v[k][j].x * v[k][j].x + v[k][j].y * v[k][j].y) + (v[k][j].z * v[k][j].z + v[k][j].w * v[k][j].w);
                s[k] = wave_sum(s[k]);
#pragma unroll
                for (int j = 0; j < 4; ++j) {
                    u32x2 w; w.x = cvt_pk_bf16(v[k][j].x, v[k][j].y); w.y = cvt_pk_bf16(v[k][j].z, v[k][j].w); *((u32x2*)(HB + (size_t)row * DM) + lane + 64 * j) = w; }
                if (lane < 16) ssq[(size_t)row * 16 + lane] = lane == 0 ? s[k] : 0.f;
            } }
    }
}

__device__ __forceinline__ void sb_unit(const bf16_t* QK, const bf16_t* VT, bf16_t* YSB, int b, int h, int qb, int lane) {
    const int r32 = lane & 31, hi = lane >> 5, rowb = b * LT, q0 = qb * 32, tq = q0 + r32, tqc = tq < LT ? tq : LT - 1;
    bf16x8 qf[4];
    { const bf16_t* qp = QK + (size_t)(rowb + tqc) * 1024 + h * 64 + hi * 8;
#pragma unroll
      for (int s = 0; s < 4; ++s) qf[s] = *(const bf16x8*)(qp + s * 16); }
    bf16x8 lt[2];
#pragma unroll
    for (int ks = 0; ks < 2; ++ks)
#pragma unroll
        for (int i = 0; i < 8; ++i) lt[ks][i] = ((16 * ks + 4 * hi + (i & 3) + 8 * (i >> 2)) > r32) ? (short)0x3F80 : (short)0;
    f32x16 o0, o1;
#pragma unroll
    for (int r = 0; r < 16; ++r) { o0[r] = 0.f; o1[r] = 0.f; }
    float carry = 0.f;
    const bf16_t* vbase = VT + (size_t)(h * 64 + r32) * MP + rowb + 4 * hi;
#define SB_LOAD(kt_, KF, VLO, VHI) do { const int key0_ = (kt_) * 32; const int krow = (rowb + key0_ + r32) < T ? (rowb + key0_ + r32) : T - 1;     \
        const bf16_t* kp = QK + (size_t)krow * 1024 + 512 + h * 64 + hi * 8; \
        _Pragma("unroll") for (int s = 0; s < 4; ++s) KF[s] = *(const bf16x8*)(kp + s * 16); \
        _Pragma("unroll") for (int mt = 0; mt < 2; ++mt) _Pragma("unroll") for (int ks = 0; ks < 2; ++ks) { const int c0 = rowb + 4 * hi + key0_ + 16 * ks, c1 = c0 + 8; const bf16_t* vrow = VT + (size_t)(h * 64 + r32 + mt * 32) * MP; \
            VLO[mt][ks] = *(const s16x4*)(vrow + (c0 < T - 4 ? c0 : T - 4)); VHI[mt][ks] = *(const s16x4*)(vrow + (c1 < T - 4 ? c1 : T - 4)); } } while (0)
    bf16x8 kf[4]; s16x4 vlo[2][2], vhi[2][2];
    SB_LOAD(qb, kf, vlo, vhi);
    for (int kt = qb; kt >= 0; --kt) {
        const int key0 = kt * 32;
        bf16x8 kfn[4]; s16x4 vlon[2][2], vhin[2][2];
        SB_LOAD((kt > 0 ? kt - 1 : 0), kfn, vlon, vhin);
        bf16x8 vf[2][2];
#pragma unroll
        for (int mt = 0; mt < 2; ++mt)
#pragma unroll
            for (int ks = 0; ks < 2; ++ks) vf[mt][ks] = (bf16x8){vlo[mt][ks][0], vlo[mt][ks][1], vlo[mt][ks][2], vlo[mt][ks][3], vhi[mt][ks][0], vhi[mt][ks][1], vhi[mt][ks][2], vhi[mt][ks][3]};
        f32x16 st;
#pragma unroll
        for (int r = 0; r < 16; ++r) st[r] = 0.f;
#pragma unroll
        for (int s = 0; s < 4; ++s) st = __builtin_amdgcn_mfma_f32_32x32x16_bf16(kf[s], qf[s], st, 0, 0, 0);
        float sp[16]; float loc = 0.f;
#pragma unroll
        for (int r = 0; r < 16; ++r) {
            const int key = key0 + (r & 3) + 8 * (r >> 2) + 4 * hi;
            const float z = st[r];
            float v = fmaxf(z, 0.f) + __builtin_amdgcn_logf(1.f + __builtin_amdgcn_exp2f(-fabsf(z)));
            v = (key < tq) ? v : 0.f;
            sp[r] = v; loc += v;
        }
        u32x4 sb0, sb1;
        sb0.x = cvt_pk_bf16(sp[0], sp[1]); sb0.y = cvt_pk_bf16(sp[2], sp[3]); sb0.z = cvt_pk_bf16(sp[4], sp[5]); sb0.w = cvt_pk_bf16(sp[6], sp[7]);
        sb1.x = cvt_pk_bf16(sp[8], sp[9]); sb1.y = cvt_pk_bf16(sp[10], sp[11]); sb1.z = cvt_pk_bf16(sp[12], sp[13]); sb1.w = cvt_pk_bf16(sp[14], sp[15]);
        f32x16 bt;
#pragma unroll
        for (int r = 0; r < 16; ++r) bt[r] = carry;
        bt = __builtin_amdgcn_mfma_f32_32x32x16_bf16(lt[0], __builtin_bit_cast(bf16x8, sb0), bt, 0, 0, 0);
        bt = __builtin_amdgcn_mfma_f32_32x32x16_bf16(lt[1], __builtin_bit_cast(bf16x8, sb1), bt, 0, 0, 0);
        float p[16];
#pragma unroll
        for (int r = 0; r < 16; ++r) {
            const int key = key0 + (r & 3) + 8 * (r >> 2) + 4 * hi;
            const float la = st[r] - sp[r] - bt[r];
            p[r] = (key < tq) ? __builtin_amdgcn_exp2f(la) : 0.f;
        }
        u32x4 pb0, pb1;
        pb0.x = cvt_pk_bf16(p[0], p[1]); pb0.y = cvt_pk_bf16(p[2], p[3]); pb0.z = cvt_pk_bf16(p[4], p[5]); pb0.w = cvt_pk_bf16(p[6], p[7]);
        pb1.x = cvt_pk_bf16(p[8], p[9]); pb1.y = cvt_pk_bf16(p[10], p[11]); pb1.z = cvt_pk_bf16(p[12], p[13]); pb1.w = cvt_pk_bf16(p[14], p[15]);
        o0 = __builtin_amdgcn_mfma_f32_32x32x16_bf16(vf[0][0], __builtin_bit_cast(bf16x8, pb0), o0, 0, 0, 0);
        o0 = __builtin_amdgcn_mfma_f32_32x32x16_bf16(vf[0][1], __builtin_bit_cast(bf16x8, pb1), o0, 0, 0, 0);
        o1 = __builtin_amdgcn_mfma_f32_32x32x16_bf16(vf[1][0], __builtin_bit_cast(bf16x8, pb0), o1, 0, 0, 0);
        o1 = __builtin_amdgcn_mfma_f32_32x32x16_bf16(vf[1][1], __builtin_bit_cast(bf16x8, pb1), o1, 0, 0, 0);
        carry += loc + __shfl_xor(loc, 32);
#pragma unroll
        for (int s = 0; s < 4; ++s) kf[s] = kfn[s];
#pragma unroll
        for (int mt = 0; mt < 2; ++mt)
#pragma unroll
            for (int ks = 0; ks < 2; ++ks) { vlo[mt][ks] = vlon[mt][ks]; vhi[mt][ks] = vhin[mt][ks]; }
        if (__all(carry > 170.f)) break;
    }
#undef SB_LOAD
    if (tq < LT) {
        bf16_t* op = YSB + (size_t)(rowb + tq) * 512 + h * 64 + 4 * hi;
#pragma unroll
        for (int rg = 0; rg < 4; ++rg) {
            u32x2 w0; w0.x = cvt_pk_bf16(o0[4 * rg], o0[4 * rg + 1]); w0.y = cvt_pk_bf16(o0[4 * rg + 2], o0[4 * rg + 3]);
            u32x2 w1; w1.x = cvt_pk_bf16(o1[4 * rg], o1[4 * rg + 1]); w1.y = cvt_pk_bf16(o1[4 * rg + 2], o1[4 * rg + 3]);
            *(u32x2*)(op + 8 * rg) = w0; *(u32x2*)(op + 32 + 8 * rg) = w1;
        }
    }
}

__device__ __forceinline__ void lora_act(CArgs a, int l, int lane, int gw, int ngw) {
    const bf16_t* RW = (const bf16_t*)(a->ws + OFF_E); bf16_t* A2 = (bf16_t*)(a->ws + OFF_I);
    float mu[5];
#pragma unroll
    for (int i = 0; i < 5; ++i) { const int col = lane + 64 * i; mu[i] = col < 288 ? a->in[I_MURW][l * RWCOLS + 1536 + col] : (l > 0 && col < 320 ? a->in[I_VMU][(l - 1) * 32 + col - 288] : 0.f); }
    for (int row0 = gw; row0 < T; row0 += 4 * ngw) {
        bf16_t ux[4][5], up[4][5]; float pm[4];
#pragma unroll
        for (int j = 0; j < 4; ++j) { const int row = row0 + j * ngw < T ? row0 + j * ngw : T - 1; const int t = row % LT;
            const bf16_t* cur = RW + (size_t)row * 2048 + 1536; const bf16_t* prv = t > 0 ? cur - 2048 : cur; pm[j] = t > 0 ? 1.f : 0.f;
#pragma unroll
            for (int i = 0; i < 5; ++i) { ux[j][i] = cur[lane + 64 * i]; up[j][i] = prv[lane + 64 * i]; } }
#pragma unroll
        for (int j = 0; j < 4; ++j) { const int row = row0 + j * ngw;
            if (row < T) {
#pragma unroll
                for (int i = 0; i < 6; ++i) {
                    const int col = lane + 64 * i; float v = 0.f;
                    if (i < 5) {
                        const float x = bf2f(ux[j][i]), xp = pm[j] * bf2f(up[j][i]);
                        const float s = x + (xp - x) * mu[i];
                        if (col < 64) v = 1.f - 2.f * __builtin_amdgcn_rcpf(fexp(2.f * s) + 1.f);
                        else if (col < 128) v = s;
                        else if (col < 288) v = fsigmoid(s);
                        else v = s;
                    }
                    A2[(size_t)row * 384 + col] = f2bf(v);
                }
            } }
    }
}

__device__ __forceinline__ void rw_finalise(CArgs a, int l, int lane, int gw, int ngw) {
    bf16_t* RW = (bf16_t*)(a->ws + OFF_E); bf16_t* LO = (bf16_t*)(a->ws + OFF_F); bf16_t* RFIN = (bf16_t*)(a->ws + OFF_I);
    bf16_t* VFIRST = (bf16_t*)(a->ws + OFF_VFIRST); bf16_t* VMIX = (bf16_t*)(a->ws + OFF_HH); float* BONUS = (float*)(a->ws + OFF_BONUS);
    const float* mu = a->in[I_MURW] + l * RWCOLS; const float* w0 = a->in[I_W0] + l * 512; const float* a0 = a->in[I_A0] + l * 512; const float* kkp = a->in[I_KK] + l * 512;
    const float* kap = a->in[I_KA] + l * 512; const float* rkp = a->in[I_RK] + l * 512; const float* vr0 = a->in[I_VRES0] + (l > 0 ? l - 1 : 0) * 512;
    float c_mr[8], c_mk[8], c_mv[8], c_w0[8], c_a0[8], c_kk[8], c_ka[8], c_rk[8], c_v0[8];
#pragma unroll
    for (int h = 0; h < 8; ++h) { const int c = h * 64 + lane; c_mr[h] = mu[c]; c_mk[h] = mu[512 + c]; c_mv[h] = mu[1024 + c]; c_w0[h] = w0[c]; c_a0[h] = a0[c]; c_kk[h] = kkp[c]; c_ka[h] = kap[c]; c_rk[h] = rkp[c]; c_v0[h] = vr0[c]; }
    for (int row = gw; row < T; row += ngw) {
        const int t = row % LT;
        bf16_t u_r[8], u_k[8], u_v[8], u_rp[8], u_kp[8], u_vp[8], u_w[8], u_a[8], u_g[8], u_f[8];
        const size_t prow = t > 0 ? (size_t)row - 1 : (size_t)row; const float pm = t > 0 ? 1.f : 0.f;
#pragma unroll
        for (int h = 0; h < 8; ++h) { const int c = h * 64 + lane; const bf16_t* cur = RW + (size_t)row * 2048 + c; const bf16_t* prv = RW + prow * 2048 + c; const bf16_t* lo = LO + (size_t)row * 2048 + c;
            u_r[h] = cur[0]; u_k[h] = cur[512]; u_v[h] = cur[1024]; u_rp[h] = prv[0]; u_kp[h] = prv[512]; u_vp[h] = prv[1024]; u_w[h] = lo[0]; u_a[h] = lo[512];
            u_g[h] = lo[1536]; u_f[h] = VFIRST[(size_t)row * 512 + c]; }
        float q_r[8], q_k[8], q_v[8], q_rp[8], q_kp[8], q_vp[8], q_w[8], q_a[8], q_g[8], q_f[8];
#pragma unroll
        for (int h = 0; h < 8; ++h) { q_r[h] = bf2f(u_r[h]); q_k[h] = bf2f(u_k[h]); q_v[h] = bf2f(u_v[h]); q_rp[h] = pm * bf2f(u_rp[h]); q_kp[h] = pm * bf2f(u_kp[h]); q_vp[h] = pm * bf2f(u_vp[h]);
            q_w[h] = bf2f(u_w[h]); q_a[h] = bf2f(u_a[h]); q_g[h] = bf2f(u_g[h]); q_f[h] = bf2f(u_f[h]); }
#pragma unroll
        for (int h = 0; h < 8; ++h) { const int c = h * 64 + lane;
            const float r = q_r[h] + (q_rp[h] - q_r[h]) * c_mr[h], kr = q_k[h] + (q_kp[h] - q_k[h]) * c_mk[h]; float vr = q_v[h] + (q_vp[h] - q_v[h]) * c_mv[h];
            const float wl = -fsoftplus(-(c_w0[h] + q_w[h])) - 0.5f, ew = fexp(wl), av = fsigmoid(c_a0[h] + q_a[h]);
            if (l == 0) VFIRST[(size_t)row * 512 + c] = f2bf(vr); else vr += (q_f[h] - vr) * fsigmoid(c_v0[h] + q_g[h]);
            float kk = kr * c_kk[h]; const float k2 = kr * (1.f + (av - 1.f) * c_ka[h]);
            float n2 = kk * kk, bon = r * k2 * c_rk[h]; wave_sum2(n2, bon);
            kk = kk * __builtin_amdgcn_rsqf(fmaxf(n2, 1e-24f));
            bf16_t* lo = LO + (size_t)row * 2048 + c;
            RFIN[(size_t)row * 512 + c] = f2bf(r); RW[(size_t)row * 2048 + 1536 + c] = f2bf(k2); VMIX[(size_t)row * 512 + c] = f2bf(vr);
            lo[0] = f2bf(-kk); lo[512] = f2bf(kk * av); lo[1536] = f2bf(ew);
            if (lane == 0) BONUS[(size_t)row * 8 + h] = bon; }
    }
}

constexpr int TC = 32;
constexpr int RW_BUF = 14336;
__device__ __forceinline__ float row16_sum(float v) {
    v += dpp0<0xB1, 0xF>(v); v += dpp0<0x4E, 0xF>(v); v += dpp0<0x141, 0xF>(v); v += dpp0<0x140, 0xF>(v); return v;
}
#define RW_BAR() do { asm volatile("s_waitcnt lgkmcnt(0)" ::: "memory"); __builtin_amdgcn_s_barrier(); asm volatile("" ::: "memory"); } while (0)
__device__ __forceinline__ void rwkv_phase(CArgs a, int l, LAS unsigned char* lds, int wave, int lane) {
    const bf16_t* RW = (const bf16_t*)(a->ws + OFF_E); const bf16_t* LO = (const bf16_t*)(a->ws + OFF_F);
    bf16_t* VFIRST = (bf16_t*)(a->ws + OFF_VFIRST); bf16_t* VMIX = (bf16_t*)(a->ws + OFF_HH);
    float* Y = (float*)(a->ws + OFF_G); float* BONUS = (float*)(a->ws + OFF_BONUS);
    LAS float* L0 = (LAS float*)lds;
    constexpr int NCH = (LT + TC - 1) / TC;
    for (int u = blockIdx.x; u < 256; u += gridDim.x) {
        const int bh = (u & 7) * 4 + (u >> 6), rg = (u >> 3) & 7, b = bh >> 3, h = bh & 7;
        if (wave >= 4) {
            const int c = h * 64 + lane, pw = wave - 4;
            const bf16_t* RFIN = (const bf16_t*)(a->ws + OFF_I);
            unsigned x_r[4], x_w[4], x_k[4], x_n[4], x_b[4], x_v[4], y_r[4], y_w[4], y_k[4], y_n[4], y_b[4], y_v[4];
            const int ts = lane >> 5, c2 = h * 64 + 2 * (lane & 31);
            typedef float f32x2p __attribute__((ext_vector_type(2)));
#define RW_LOAD(S, t0_) do { _Pragma("unroll") for (int g = 0; g < 4; ++g) { int t = (t0_) + pw + 4 * (2 * g + ts); t = t < LT ? t : LT - 1;     \
                const size_t row = (size_t)b * LT + t; const bf16_t* lo = LO + row * 2048 + c2; \
                { const int to_ = (t0_) + pw + 4 * (2 * g + ts); const int tr_ = (to_ < LT ? to_ : LT) - 1; const size_t rowr = (size_t)b * LT + (tr_ > 0 ? tr_ : 0); S##_r[g] = *(const unsigned*)(RFIN + rowr * 512 + c2); }     \
                S##_w[g] = *(const unsigned*)(lo + 1536); S##_k[g] = *(const unsigned*)(RW + row * 2048 + 1536 + c2); \
                S##_n[g] = *(const unsigned*)lo; S##_b[g] = *(const unsigned*)(lo + 512); S##_v[g] = *(const unsigned*)(VMIX + row * 512 + c2); } } while (0)
#define RW_FINAL(S, t0_, buf_) do { LAS float* B_ = L0 + (buf_) * RW_BUF; _Pragma("unroll") for (int g = 0; g < 4; ++g) { const int tt = pw + 4 * (2 * g + ts); \
                *(LAS f32x4*)(B_ + tt * 128 + 4 * (lane & 31)) = (f32x4){fexp(-bflo(S##_w[g])), fexp(-bfhi(S##_w[g])), bflo(S##_k[g]), bfhi(S##_k[g])}; \
                *(LAS f32x4*)(B_ + 4096 + tt * 128 + 4 * (lane & 31)) = (f32x4){bflo(S##_n[g]), bflo(S##_r[g]), bfhi(S##_n[g]), bfhi(S##_r[g])};     \
                *(LAS f32x2p*)(B_ + 8192 + tt * 128 + 2 * (lane & 31)) = (f32x2p){bflo(S##_b[g]), bfhi(S##_b[g])}; \
                *(LAS f32x2p*)(B_ + 12288 + tt * 64 + 2 * (lane & 31)) = (f32x2p){bflo(S##_v[g]), bfhi(S##_v[g])}; } } while (0)
            RW_LOAD(x, 0); RW_LOAD(y, TC); RW_FINAL(x, 0, 0);
            RW_BAR();
            for (int ci = 0; ci < NCH; ++ci) {
                const int t0 = ci * TC;
                if (ci & 1) { if (ci + 2 < NCH) RW_LOAD(y, t0 + 2 * TC); if (ci + 1 < NCH) RW_FINAL(x, t0 + TC, 0); }
                else        { if (ci + 2 < NCH) RW_LOAD(x, t0 + 2 * TC); if (ci + 1 < NCH) RW_FINAL(y, t0 + TC, 1); }
                RW_BAR();
            }
#undef RW_LOAD
#undef RW_FINAL
        } else {
            const int q = lane & 31, rho = rg * 8 + wave * 2 + (lane >> 5);
            typedef float f32x2v __attribute__((ext_vector_type(2)));
            f32x2v s = (f32x2v){0.f, 0.f};
            RW_BAR();
            for (int ci = 0; ci < NCH; ++ci) {
                const int t0 = ci * TC, n = (LT - t0) < TC ? (LT - t0) : TC;
                const LAS float* B_ = L0 + (ci & 1) * RW_BUF;
                float yb = 0.f, yb1 = 0.f, ylast = 0.f; const int q16 = lane & 15; const bool yrow = (lane & 16) != 0;
#define RW_ISSUE_A(tt_, R2_, WK_, NB_, V2_) do { \
                    asm volatile("ds_read_b128 %0, %1 offset:%2" : "=v"(NB_) : "v"(abase), "i"(16384 + (tt_) * 512)); asm volatile("ds_read_b128 %0, %1 offset:%2" : "=v"(WK_) : "v"(abase), "i"((tt_) * 512)); \
                    asm volatile("ds_read2st64_b32 %0, %1 offset0:%2 offset1:%3" : "=v"(V2_) : "v"(vbase), "i"(192 + (tt_)), "i"(193 + (tt_))); \
                    asm volatile("ds_read2st64_b64 %0, %1 offset0:%2 offset1:%3" : "=v"(R2_) : "v"(rbase), "i"(64 + (tt_)), "i"(65 + (tt_))); } while (0)
#define RW_ISSUE_B(tt_, WK_, NB_) do { \
                    asm volatile("ds_read_b128 %0, %1 offset:%2" : "=v"(NB_) : "v"(abase), "i"(16384 + (tt_) * 512)); asm volatile("ds_read_b128 %0, %1 offset:%2" : "=v"(WK_) : "v"(abase), "i"((tt_) * 512)); } while (0)
#define RW_WAIT_A(NN_, R2_, WK_, NB_, V2_) asm volatile("s_waitcnt lgkmcnt(" #NN_ ")" : "+v"(R2_), "+v"(WK_), "+v"(NB_), "+v"(V2_))
#define RW_WAIT_B(NN_, WK_, NB_) asm volatile("s_waitcnt lgkmcnt(" #NN_ ")" : "+v"(WK_), "+v"(NB_))
#define RW_SUM32_2(x_, y_) do { x_ += dpp0<0xB1, 0xF>(x_); y_ += dpp0<0xB1, 0xF>(y_); x_ += dpp0<0x4E, 0xF>(x_); y_ += dpp0<0x4E, 0xF>(y_); \
                    x_ += dpp0<0x141, 0xF>(x_); y_ += dpp0<0x141, 0xF>(y_); x_ += dpp0<0x140, 0xF>(x_); y_ += dpp0<0x140, 0xF>(y_); \
                      \
                    const auto sw_ = __builtin_amdgcn_permlane16_swap(__float_as_uint(x_), __float_as_uint(y_), false, false); \
                    const float cb_ = __uint_as_float(sw_[0]) + __uint_as_float(sw_[1]); y_ = cb_; \
                    x_ = __builtin_bit_cast(float, __builtin_amdgcn_update_dpp(__builtin_bit_cast(int, cb_), __builtin_bit_cast(int, cb_), 0x142, 0xA, 0xF, false)); } while (0)
#define RW_STEP(tt_, Bv_, WK_, NR_, V_) do { const f32x2v W_ = (f32x2v){WK_.x, WK_.y}, K_ = (f32x2v){WK_.z, WK_.w}; \
                    const f32x2v tw_ = s * W_ + V_ * K_;     \
                    f32x2v p_ = (f32x2v){s.x, s.x} * (f32x2v){NR_.x, NR_.y}; p_ = (f32x2v){s.y, s.y} * (f32x2v){NR_.z, NR_.w} + p_;     \
                    float sa = p_.x, yv = p_.y; RW_SUM32_2(sa, yv); \
                    if ((tt_) == 0) ylast = yv; else if (q16 == (((tt_) - 1) & 15)) { if ((tt_) - 1 < 16) yb = yv; else yb1 = yv; } s = tw_ + sa * Bv_; } while (0)
                static_assert(TC == 32, "asm offsets assume TC = 32");
                const unsigned abase = (unsigned)(size_t)B_ + 16u * (unsigned)q, rbase = (unsigned)(size_t)B_ + 8u * (unsigned)q, vbase = (unsigned)(size_t)B_ + 4u * (unsigned)rho;
                f32x4 r2, wkA, nbA, wkB, nbB; f32x2v v2;
#define RW_PAIR(tt_) do { RW_ISSUE_B((tt_) + 1, wkB, nbB); RW_WAIT_A(2, r2, wkA, nbA, v2); \
                    const f32x2v rA_ = (f32x2v){r2.x, r2.y}, rB_ = (f32x2v){r2.z, r2.w}; const float vA_ = v2.x, vB_ = v2.y; RW_STEP((tt_), rA_, wkA, nbA, vA_); \
                    RW_ISSUE_A(((tt_) + 2 < TC ? (tt_) + 2 : (tt_)), r2, wkA, nbA, v2); RW_WAIT_B(4, wkB, nbB); RW_STEP((tt_) + 1, rB_, wkB, nbB, vB_); } while (0)
                RW_ISSUE_A(0, r2, wkA, nbA, v2);
                RW_PAIR(0); RW_PAIR(2); RW_PAIR(4); RW_PAIR(6); RW_PAIR(8); RW_PAIR(10); RW_PAIR(12); RW_PAIR(14);
                if (n > 16) { RW_PAIR(16); RW_PAIR(18); RW_PAIR(20); RW_PAIR(22); RW_PAIR(24); RW_PAIR(26); RW_PAIR(28); RW_PAIR(30); }
#undef RW_PAIR
                RW_WAIT_A(0, r2, wkA, nbA, v2);
#undef RW_ISSUE_A
#undef RW_ISSUE_B
#undef RW_WAIT_A
#undef RW_WAIT_B
#undef RW_STEP
                if (yrow) {
                    if (q16 < n - 1) Y[((size_t)b * LT + t0 + q16) * 512 + h * 64 + rho] = yb;
                    if (q16 + 16 < n - 1) Y[((size_t)b * LT + t0 + q16 + 16) * 512 + h * 64 + rho] = yb1;
                    if (ci > 0 && q16 == 0) Y[((size_t)b * LT + t0 - 1) * 512 + h * 64 + rho] = ylast;
                }
                RW_BAR();
            }
            { const LAS float* Bl_ = L0 + ((NCH - 1) & 1) * RW_BUF + 4096 + (LT - (NCH - 1) * TC) * 128 + 4 * q; float yv = s.x * Bl_[1] + s.y * Bl_[3], dummy = 0.f; RW_SUM32_2(yv, dummy);
              if (q == 0) Y[((size_t)b * LT + LT - 1) * 512 + h * 64 + rho] = yv; }
#undef RW_SUM32_2
        }
    }
}

__device__ __forceinline__ void rw_post(CArgs a, int l, int lane, int gw, int ngw) {
    const float* Y = (const float*)(a->ws + OFF_G); const bf16_t* LO = (const bf16_t*)(a->ws + OFF_F); const bf16_t* VMIX = (const bf16_t*)(a->ws + OFF_HH);
    const float* BONUS = (const float*)(a->ws + OFF_BONUS); bf16_t* YRW = (bf16_t*)(a->ws + OFF_I);
    float lw[NH], lb[NH];
#pragma unroll
    for (int h = 0; h < NH; ++h) { lw[h] = a->in[I_LNW][l * 512 + h * 64 + lane]; lb[h] = a->in[I_LNB][l * 512 + h * 64 + lane]; }
    float yv[NH], bo[NH]; bf16_t vm[NH], gg[NH];
#define RP_LOAD(r_, YV, BO, VM, GG) do { const int rr_ = (r_) < T ? (r_) : T - 1; _Pragma("unroll") for (int h = 0; h < NH; ++h) { const int c = h * 64 + lane; \
        YV[h] = Y[(size_t)rr_ * 512 + c]; BO[h] = BONUS[(size_t)rr_ * 8 + h]; VM[h] = VMIX[(size_t)rr_ * 512 + c]; GG[h] = LO[(size_t)rr_ * 2048 + 1024 + c]; } } while (0)
    RP_LOAD(gw, yv, bo, vm, gg);
    for (int row = gw; row < T; row += ngw) {
        float yn_[NH], bn_[NH]; bf16_t vn_[NH], gn_[NH];
        RP_LOAD(row + ngw, yn_, bn_, vn_, gn_);
#pragma unroll
        for (int h = 0; h < NH; ++h) {
            const int c = h * 64 + lane;
            const float y = yv[h];
            const float mean = wave_sum(y) * (1.f / 64.f), d = y - mean;
            const float var = wave_sum(d * d) * (1.f / 64.f);
            const float yn = d * rsqrtf(var + GN_EPS) * lw[h] + lb[h];
            const float o = (yn + bo[h] * bf2f(vm[h])) * bf2f(gg[h]);
            YRW[(size_t)row * 512 + c] = f2bf(o);
        }
#pragma unroll
        for (int h = 0; h < NH; ++h) { yv[h] = yn_[h]; bo[h] = bn_[h]; vm[h] = vn_[h]; gg[h] = gn_[h]; }
    }
#undef RP_LOAD
}

__device__ __forceinline__ void final_out(CArgs a, int lane, int gw, int ngw) {
    const bf16_t* HB = (const bf16_t*)(a->ws + OFF_HB); const float* ssq = (const float*)(a->ws + OFF_SSQ);
    f32x4 g[4];
#pragma unroll
    for (int j = 0; j < 4; ++j) g[j] = *((const f32x4*)a->in[I_NFIN] + lane + 64 * j);
    for (int o0 = gw; o0 < NB * SEQ; o0 += 4 * ngw) {
        u32x2 hv[4][4]; float rs[4];
#pragma unroll
        for (int k = 0; k < 4; ++k) { const int o = o0 + k * ngw < NB * SEQ ? o0 + k * ngw : NB * SEQ - 1; const int b = o / SEQ, s = o - b * SEQ, row = b * LT + NMETA + s;
            rs[k] = row_rstd(ssq, row);
#pragma unroll
            for (int j = 0; j < 4; ++j) hv[k][j] = *((const u32x2*)(HB + (size_t)row * DM) + lane + 64 * j); }
#pragma unroll
        for (int k = 0; k < 4; ++k) { const int o = o0 + k * ngw;
            if (o < NB * SEQ) {
#pragma unroll
                for (int j = 0; j < 4; ++j) { const f32x4 v = (f32x4){bflo(hv[k][j].x), bfhi(hv[k][j].x), bflo(hv[k][j].y), bfhi(hv[k][j].y)}; *((f32x4*)(a->out + (size_t)o * DM) + lane + 64 * j) = v * rs[k] * g[j]; }
            } }
    }
}

#define RLX_AGENT __ATOMIC_RELAXED, __HIP_MEMORY_SCOPE_AGENT
#define XB_TMO      128
#define XB_XCNT(j)  (256  + 64 * (j))
#define XB_XSUB(j)  (1280 + 64 * (j))
#define XB_XGEN(j)  (2304 + 64 * (j))
#define XB_TOP      3328
#define XB_TOPGEN   3392
#define XCD_BAR_WORDS 3456
#define XB_SPIN_CAP (1u << 18)

__device__ __forceinline__ unsigned xb_ld(unsigned* p)              { return __hip_atomic_load(p, __ATOMIC_RELAXED, __HIP_MEMORY_SCOPE_AGENT); }
__device__ __forceinline__ unsigned xb_add(unsigned* p, unsigned v) { return __hip_atomic_fetch_add(p, v, __ATOMIC_RELAXED, __HIP_MEMORY_SCOPE_AGENT); }
__device__ __forceinline__ unsigned xb_xcc_id() { return (unsigned)__builtin_amdgcn_s_getreg((3 << 11) | 20) & 0xFu; }
#define XB_SPIN(cond, bar) do { unsigned _sp = 0; while (cond) { __builtin_amdgcn_s_sleep(1); \
    if ((++_sp & 255u) == 0u) { if (xb_ld(&(bar)[XB_TMO])) break; if (_sp > XB_SPIN_CAP) { atomicAdd(&(bar)[XB_TMO], 1u); break; } } } } while (0)

struct XcdBarrier {
    unsigned* bar; unsigned x;
    volatile LAS unsigned* st;
};

__device__ __forceinline__ XcdBarrier xcd_barrier_post(unsigned* bar, volatile LAS unsigned* st) {
    XcdBarrier b; b.bar = bar; b.x = xb_xcc_id(); b.st = st;
    if (threadIdx.x == 0) (void)xb_add(&bar[XB_XCNT(b.x)], 1u);
    return b;
}
__device__ __forceinline__ void xcd_barrier_complete(unsigned* bar, unsigned x, unsigned& nloc, unsigned& nx) {
    const unsigned G = gridDim.x * gridDim.y * gridDim.z;
    unsigned sum, cnt, mine, sp = 0u;
    for (;;) {
        sum = 0u; cnt = 0u; mine = 0u;
#pragma unroll
        for (unsigned j = 0; j < 16; ++j) { const unsigned c = xb_ld(&bar[XB_XCNT(j)]); sum += c; cnt += (c > 0u) ? 1u : 0u; mine = (j == x) ? c : mine; }
        if (sum == G) break;
        __builtin_amdgcn_s_sleep(1);
        if ((++sp & 255u) == 0u) { if (xb_ld(&bar[XB_TMO])) break; if (sp > XB_SPIN_CAP) { atomicAdd(&bar[XB_TMO], 1u); break; } }
    }
    nloc = mine > 0u ? mine : 1u; nx = cnt > 0u ? cnt : 1u;
}

__device__ __forceinline__ void xcd_barrier(const XcdBarrier& b) {
    asm volatile("s_waitcnt vmcnt(0)" ::: "memory");
    __syncthreads();
    if (threadIdx.x == 0) {
        unsigned* bar = b.bar;
        __builtin_amdgcn_s_waitcnt(0);
        unsigned nloc = b.st[0], nx = b.st[1];
        if (nloc == 0u) { xcd_barrier_complete(bar, b.x, nloc, nx); b.st[0] = nloc; b.st[1] = nx; }
        const unsigned old = xb_add(&bar[XB_XSUB(b.x)], 1u);
        const unsigned gen = old / nloc;
        if (old + 1u == (gen + 1u) * nloc) {
            __builtin_amdgcn_fence(__ATOMIC_RELEASE, "agent");
            asm volatile("s_waitcnt vmcnt(0)" ::: "memory");
            const unsigned og = xb_add(&bar[XB_TOP], 1u);
            const unsigned tg = og / nx;
            if (og + 1u == (tg + 1u) * nx) xb_add(&bar[XB_TOPGEN], 1u);
            else XB_SPIN(xb_ld(&bar[XB_TOPGEN]) == tg, bar);
            __builtin_amdgcn_fence(__ATOMIC_ACQUIRE, "agent");
            xb_add(&bar[XB_XGEN(b.x)], 1u);
            asm volatile("s_waitcnt vmcnt(0)" ::: "memory");
        } else {
            XB_SPIN(xb_ld(&bar[XB_XGEN(b.x)]) == gen, bar);
            __builtin_amdgcn_fence(__ATOMIC_ACQUIRE, "agent");
            asm volatile("s_waitcnt vmcnt(0)" ::: "memory");
        }
    }
    __syncthreads();
}


#if PROBE_SYNC2
#define PROBE_EXTRA_SYNC asm volatile("s_waitcnt vmcnt(0)" ::: "memory"); grid.sync(); if (threadIdx.x == 0) { __builtin_amdgcn_fence(__ATOMIC_ACQUIRE, "agent"); asm volatile("s_waitcnt vmcnt(0)" ::: "memory"); } __syncthreads();
#else
#define PROBE_EXTRA_SYNC
#endif
#define GSYNC() do { asm volatile("s_waitcnt vmcnt(0)" ::: "memory"); grid.sync(); \
    if (threadIdx.x == 0) { __builtin_amdgcn_fence(__ATOMIC_ACQUIRE, "agent"); asm volatile("s_waitcnt vmcnt(0)" ::: "memory"); } \
    __syncthreads(); PROBE_EXTRA_SYNC } while (0)
#define XSYNC() xcd_barrier(xbar)
#ifndef AL1
#define AL1 false
#endif
#ifndef AL2
#define AL2 true
#endif
#ifndef AL3
#define AL3 true
#endif
#ifndef AL4
#define AL4 false
#endif
#ifndef AL5
#define AL5 true
#endif
#ifndef AL6
#define AL6 true
#endif
#ifndef AL7
#define AL7 true
#endif
#ifndef AL8
#define AL8 true
#endif
#ifndef AL9
#define AL9 true
#endif
#define COMMA ,
#ifndef GALIGN
#define GALIGN false
#endif
#ifndef GSP2
#define GSP2 true
#endif
#define GEMM_CALLX(EpiT, AL, gA, gB, gM, gN, gK, E) for (int rep_ = 0; rep_ < ((#AL)[2] == '7' || (#AL)[2] == '9' || (#AL)[2] == '6' ? 1 : 1 + PROBE_GEMM2); ++rep_) do { pg8::Gemm g_{(const bf16_t*)(gA), (const bf16_t*)(gB), (gM), (gN), (gK)}; pg8::StaticOrder S_; S_.init((gM), (gN), (int)gridDim.x, (int)blockIdx.x); \
    pg8::gemm_phase<EpiT, pg8::StaticOrder, AL, GSP2>(lds, g_, S_, (E)); } while (0)

__global__ void __launch_bounds__(NTHREADS, 2) fwd_megakernel(Args a_unused) {
    const CArgs ap = (CArgs)__builtin_amdgcn_kernarg_segment_ptr();
#define a opq_args(ap)
    extern __shared__ __attribute__((aligned(16))) unsigned char lds_raw[];
    LAS unsigned char* lds = (LAS unsigned char*)lds_raw;
    cg::grid_group grid = cg::this_grid();
    volatile LAS unsigned* bst = (volatile LAS unsigned*)(lds + 140032);
    if (threadIdx.x < 2) bst[threadIdx.x] = 0u;
    __syncthreads();
    const XcdBarrier xbar = xcd_barrier_post((unsigned*)(((CArgs)__builtin_amdgcn_kernarg_segment_ptr())->ws + OFF_BAR), bst);
    const int tid = threadIdx.x, lane = tid & 63, wave = __builtin_amdgcn_readfirstlane(tid >> 6);
    const int gw = blockIdx.x * NWAVES + wave, ngw = gridDim.x * NWAVES;
#define ws (opq_args(ap)->ws)
#define ssq ((float*)(ws + OFF_SSQ))

#if !defined(NO_P0)
    init_rows(a, lane, gw, ngw);
    convert_mix_weights(a, 0, lds, wave, lane, gw, ngw);
#endif
    GSYNC();

    for (int l = 0; l < DEPTH; ++l) {
#ifndef NO_PH1
        { EpiStore<0, true> E{(bf16_t*)(ws + OFF_G), 1024, (bf16_t*)(ws + OFF_E), 2048, 4, ssq, C2, 2};
          GEMM_CALLX(EpiStore<0 COMMA true>, AL2, ws + OFF_HB, ws + OFF_W1A, MB, 3072, 1024, E);
          TStore<0, true> TE{{(bf16_t*)(ws + OFF_G), 1024, (bf16_t*)(ws + OFF_E), 2048, 1024, ssq, C2, 512}};
          tail_gemm(lds, (const bf16_t*)(ws + OFF_HB) + (size_t)MB * 1024, (const bf16_t*)(ws + OFF_W1A), 1024, 3072, TE, wave, opq(lane), 128); }
        { EpiVT E{(bf16_t*)(ws + OFF_HH), MP, ssq};
          GEMM_CALLX(EpiVT, AL3, ws + OFF_WV, ws + OFF_HB, 512, MB, 1024, E);
          TVT TE{(bf16_t*)(ws + OFF_HH), MP, ssq};
          tail_gemm(lds, (const bf16_t*)(ws + OFF_HB) + (size_t)MB * 1024, (const bf16_t*)(ws + OFF_WV), 1024, 512, TE, wave, opq(lane), 176);
          { const int cb = gridDim.x >= 256 ? 128 : 0; if ((int)blockIdx.x >= cb) convert_ffn_weights(a, l, lds, wave, opq(lane), ((int)blockIdx.x - cb) * NWAVES + wave, ((int)gridDim.x - cb) * NWAVES); } }
#endif
        XSYNC();
#ifndef NO_PH2
        if (ngw == 2048) {
            if (gw < 32) { for (int k = 0; k < 3; ++k) sb_unit((const bf16_t*)(ws + OFF_G), (const bf16_t*)(ws + OFF_HH), (bf16_t*)(ws + OFF_J), gw >> 3, gw & 7, k < 2 ? k : 128, opq(lane)); }
            else { for (int k = 0; k < 2; ++k) { const int i = (gw - 32) + k * 2016, bh = i / 126, qb = 2 + (i - bh * 126); sb_unit((const bf16_t*)(ws + OFF_G), (const bf16_t*)(ws + OFF_HH), (bf16_t*)(ws + OFF_J), bh >> 3, bh & 7, qb, opq(lane)); } }
        } else
        for (int u = gw; u < NB * NH * 129; u += ngw) { const int bh = u / 129, qb = u - bh * 129; sb_unit((const bf16_t*)(ws + OFF_G), (const bf16_t*)(ws + OFF_HH), (bf16_t*)(ws + OFF_J), bh >> 3, bh & 7, qb, opq(lane)); }
        for (int rep_ = 0; rep_ < 1 + PROBE_MISC2; ++rep_) lora_act(a, l, opq(lane), gw, ngw);
#endif
        XSYNC();
#ifndef NO_PH3
        { EpiStore<0, false> E{(bf16_t*)(ws + OFF_F), 2048, (bf16_t*)(ws + OFF_F), 2048, 1 << 20, nullptr, 1.f, 0};
          GEMM_CALLX(EpiStore<0 COMMA false>, AL4, ws + OFF_I, ws + OFF_WL, MB, 2048, 384, E);
          TStore<0, false> TE{{(bf16_t*)(ws + OFF_F), 2048, (bf16_t*)(ws + OFF_F), 2048, 1 << 30, nullptr, 1.f, 0}};
          tail_gemm(lds, (const bf16_t*)(ws + OFF_I) + (size_t)MB * 384, (const bf16_t*)(ws + OFF_WL), 384, 2048, TE, wave, opq(lane)); }
#endif
        XSYNC();
        rw_finalise(a, l, opq(lane), gw, ngw);
        XSYNC();
#ifndef NO_PH4
        rwkv_phase(a, l, lds, wave, opq(lane));
#if PROBE_RW2
        rwkv_phase(a, l, lds, wave, opq(lane));
#endif
#endif
        XSYNC();
#ifndef NO_PH5
        for (int rep_ = 0; rep_ < 1 + PROBE_MISC2; ++rep_) rw_post(a, l, opq(lane), gw, ngw);
        { EpiStore<1, true> E{(bf16_t*)(ws + OFF_E), 2048, (bf16_t*)(ws + OFF_E), 2048, 1 << 20, ssq, 1.f, 0};
          GEMM_CALLX(EpiStore<1 COMMA true>, AL5, ws + OFF_HB, ws + OFF_WG, MB, 2048, 1024, E);
          TStore<1, true> TE{{(bf16_t*)(ws + OFF_E), 2048, (bf16_t*)(ws + OFF_E), 2048, 1 << 30, ssq, 1.f, 0}};
          tail_gemm(lds, (const bf16_t*)(ws + OFF_HB) + (size_t)MB * 1024, (const bf16_t*)(ws + OFF_WG), 1024, 2048, TE, wave, opq(lane)); }
#endif
        XSYNC();
#ifndef NO_PH6
        for (int br = 0; br < 2; ++br) {
            EpiGateMul E{(bf16_t*)(ws + OFF_F), (const bf16_t*)(ws + OFF_E), 2048, br * 1024, br};
            GEMM_CALLX(EpiGateMul, AL6, br ? ws + OFF_I : ws + OFF_J, br ? ws + OFF_WRW : ws + OFF_WSB, MB, 1024, 512, E);
            TGateMul TE{(bf16_t*)(ws + OFF_F), (const bf16_t*)(ws + OFF_E), 2048, br * 1024, br};
            tail_gemm(lds, (const bf16_t*)(br ? ws + OFF_I : ws + OFF_J) + (size_t)MB * 512, (const bf16_t*)(br ? ws + OFF_WRW : ws + OFF_WSB), 512, 1024, TE, wave, opq(lane));
        }
#endif
        XSYNC();
#ifndef NO_PH7
        { EpiResid E{(bf16_t*)(ws + OFF_HB), ssq + (size_t)MP * 16};
          GEMM_CALLX(EpiResid, AL7, ws + OFF_F, ws + OFF_WO, MB, 1024, 1024, E);
          TResid TE{(bf16_t*)(ws + OFF_HB), ssq + (size_t)MP * 16};
          tail_gemm(lds, (const bf16_t*)(ws + OFF_F) + (size_t)MB * 1024, (const bf16_t*)(ws + OFF_WO), 1024, 1024, TE, wave, opq(lane)); }
#endif
        XSYNC();
#ifndef NO_PH8
        { EpiSwiglu E{(bf16_t*)(ws + OFF_E), ssq + (size_t)MP * 16};
          GEMM_CALLX(EpiSwiglu, AL8, ws + OFF_HB, ws + OFF_WF1, MB, 2 * FFH, 1024, E);
          TSwiglu TE{(bf16_t*)(ws + OFF_E), ssq + (size_t)MP * 16};
          tail_gemm(lds, (const bf16_t*)(ws + OFF_HB) + (size_t)MB * 1024, (const bf16_t*)(ws + OFF_WF1), 1024, 2 * FFH, TE, wave, opq(lane), 128);
          { const int cb = gridDim.x >= 256 ? 128 : 0; if (l + 1 < DEPTH && (int)blockIdx.x >= cb) convert_mix_weights(a, l + 1, lds, wave, opq(lane), ((int)blockIdx.x - cb) * NWAVES + wave, ((int)gridDim.x - cb) * NWAVES); } }
#endif
        XSYNC();
#ifndef NO_PH9
        { EpiResid E{(bf16_t*)(ws + OFF_HB), ssq};
          GEMM_CALLX(EpiResid, AL9, ws + OFF_E, ws + OFF_WF2, MB, 1024, FFH, E);
          TResid TE{(bf16_t*)(ws + OFF_HB), ssq};
          tail_gemm(lds, (const bf16_t*)(ws + OFF_E) + (size_t)MB * FFH, (const bf16_t*)(ws + OFF_WF2), FFH, 1024, TE, wave, opq(lane)); }
#endif
        XSYNC();
    }
    final_out(a, opq(lane), gw, ngw);
#undef a
#undef ws
#undef ssq
}

extern "C" void kernel_launch(void* const* d_in, const int* in_sizes, int n_in, void* d_out, int out_size, void* d_ws, size_t ws_size, hipStream_t stream) {
    static int grid = 0;
    if (grid == 0) {
        if (n_in != 26 || out_size != NB * SEQ * DM || ws_size < WS_END) { fprintf(stderr, "kernel_launch: unexpected problem (n_in %d, out %d, ws %zu < %zu)\n", n_in, out_size, ws_size, (size_t)WS_END); grid = -1; return; }
        int dev = 0, cus = 0, per_cu = 0;
        hipGetDevice(&dev); hipDeviceGetAttribute(&cus, hipDeviceAttributeMultiprocessorCount, dev);
        if (hipFuncSetAttribute((const void*)fwd_megakernel, hipFuncAttributeMaxDynamicSharedMemorySize, LDS_BYTES) != hipSuccess) { fprintf(stderr, "kernel_launch: hipFuncSetAttribute failed\n"); grid = -1; return; }
        if (hipOccupancyMaxActiveBlocksPerMultiprocessor(&per_cu, (const void*)fwd_megakernel, NTHREADS, LDS_BYTES) != hipSuccess || per_cu < 1) per_cu = 1;
        (void)hipGetLastError();
        grid = cus * per_cu;
    }
    if (grid < 0) return;
    if (hipMemsetAsync((char*)d_ws + OFF_BAR, 0, 16384, stream) != hipSuccess) { fprintf(stderr, "kernel_launch: hipMemsetAsync failed\n"); return; }
    Args a{};
    for (int i = 0; i < 26; ++i) a.in[i] = (const float*)d_in[i];
    a.out = (float*)d_out; a.ws = (unsigned char*)d_ws;
    void* args[] = {&a};
    hipError_t e = hipLaunchCooperativeKernel((const void*)fwd_megakernel, dim3(grid), dim3(NTHREADS), args, LDS_BYTES, stream);
    if (e != hipSuccess) fprintf(stderr, "cooperative launch failed: %s (grid %d)\n", hipGetErrorString(e), grid);
}
```

```cpp
#include <hip/hip_runtime.h>
#include <hip/hip_cooperative_groups.h>
#include <cstdio>
#include <cstdint>
namespace cg = cooperative_groups;
#ifndef PROBE_RW2
#define PROBE_RW2 0
#endif
#ifndef PROBE_SYNC2
#define PROBE_SYNC2 0
#endif
#ifndef PROBE_GEMM2
#define PROBE_GEMM2 0
#endif
#ifndef PROBE_MISC2
#define PROBE_MISC2 0
#endif
#ifndef PROBE_SB2
#define PROBE_SB2 0
#endif
#ifndef PROBE_CV2
#define PROBE_CV2 0
#endif
namespace pg8 {
#define PG8_LAS __attribute__((address_space(3)))
typedef unsigned short bf16_t;
typedef short bf16x8 __attribute__((ext_vector_type(8)));
typedef float f32x4 __attribute__((ext_vector_type(4)));
typedef unsigned u32x4 __attribute__((ext_vector_type(4)));
constexpr int BM = 256, BK = 64, HALF = 128, HTB = HALF * BK * 2  , STAGE_BYTES = 8 * HTB, NXCD = 8, WGM = 8;

__host__ __device__ __forceinline__ int lds_byte(int r, int c) { const int st = (r >> 4) * 2 + (c >> 5), rr = r & 15, cc = c & 31, ob = rr * 64 + cc * 2; return st * 1024 + (ob ^ (((ob >> 9) & 1) << 5)); }
__host__ __device__ __forceinline__ void stage_rc(int b, int& R, int& C) { const int st = b / 1024, sb = b % 1024, swz = sb ^ (((sb >> 9) & 1) << 5); R = (st >> 1) * 16 + swz / 64; C = (st & 1) * 32 + (swz % 64) / 2; }
__host__ __device__ __forceinline__ int perm32(int rho) { const int n = rho >> 4, i = rho & 15; return 8 * (i >> 2) + 4 * n + (i & 3); }

struct Unit { int pm, pn; };
struct Gemm { const bf16_t* A; const bf16_t* Bt; int M, N, K; };

struct StaticOrder {
    int nM, nN, nwg, G, c;
    __host__ __device__ void init(int M, int N, int G_, int c_) { nM = M / BM; nN = N / BM; nwg = nM * nN; G = G_; c = c_; }
    __host__ __device__ bool next(int i, Unit& u) const {
        const long L = (long)i * G + c; if (L >= nwg) return false;
        int wgid = (int)L; { const int q = nwg / NXCD, r = nwg % NXCD, xcd = wgid % NXCD, off = wgid / NXCD; wgid = (xcd < r ? xcd * (q + 1) : r * (q + 1) + (xcd - r) * q) + off; }
        const int nig = WGM * nN, gid = wgid / nig, fm = gid * WGM, gsz = (nM - fm) < WGM ? (nM - fm) : WGM;
        u.pm = fm + ((wgid % nig) % gsz); u.pn = (wgid % nig) / gsz; return true;
    }
    __device__ __forceinline__ void a_ready(const Unit&) const {}
    __device__ __forceinline__ void done(const Unit&) const {}
};

__device__ __forceinline__ unsigned cvt_pk_bf16(float lo, float hi) { unsigned r; asm volatile("v_cvt_pk_bf16_f32 %0, %1, %2" : "=v"(r) : "v"(lo), "v"(hi)); return r; }
template <class Epi, class Sched, bool ALIGN_EPI = false, bool SP2 = false>
__device__ __forceinline__ void gemm_phase(PG8_LAS unsigned char* lds, const Gemm g, const Sched& S, const Epi& E) {
    int tid_ = threadIdx.x; asm volatile("" : "+v"(tid_)); const int tid = tid_, wid = __builtin_amdgcn_readfirstlane(tid >> 6), lane = tid & 63, wr = wid >> 2, wc = wid & 3, fr = lane & 15, fq = lane >> 4;
    const int K = g.K, nt = K / BK;
    unsigned voffA[2], voffB[2];
#pragma unroll
    for (int i = 0; i < 2; ++i) { int R, C; stage_rc(tid * 16 + i * 8192, R, C); const int Rb = Epi::PERM ? ((R & ~31) + perm32(R & 31)) : R;
        voffA[i] = (unsigned)(R * K + C) * 2u; voffB[i] = (unsigned)(Rb * K + C) * 2u; }
    const size_t kstep = (size_t)(BK * 2);
    const size_t hstep = (size_t)HALF * K * 2;
    const size_t tstep = 2 * hstep;
    const unsigned ldsw = (unsigned)wid * 1024u;
    const int aoff = lds_byte(wr * 64 + fr, fq * 8), boff = lds_byte(wc * 32 + fr, fq * 8);
#define PG8_SA(b, h) (((b) * 2 + (h)) * HTB)
#define PG8_SB(b, h) ((4 + (b) * 2 + (h)) * HTB)
#define PG8_STAGE(bufoff, gbase, voff) do { _Pragma("unroll") for (int _i = 0; _i < 2; ++_i) \
        __builtin_amdgcn_global_load_lds((const unsigned*)((const char*)(gbase) + (voff)[_i]), (PG8_LAS unsigned*)(lds + (bufoff) + ldsw + _i * 8192), 16, 0, 0); } while (0)
#define PG8_LDA(dst, b, h) do { _Pragma("unroll") for (int m = 0; m < 4; ++m) _Pragma("unroll") for (int k = 0; k < 2; ++k) dst[m][k] = *(const PG8_LAS bf16x8*)(lds + PG8_SA(b, h) + aoff + m * 2048 + k * 1024); } while (0)
#define PG8_LDB(dst, b, h) do { _Pragma("unroll") for (int n = 0; n < 2; ++n) _Pragma("unroll") for (int k = 0; k < 2; ++k) dst[n][k] = *(const PG8_LAS bf16x8*)(lds + PG8_SB(b, h) + boff + n * 2048 + k * 1024); } while (0)
#define PG8_MMA(ai, bj, At, Bt) do { __builtin_amdgcn_s_setprio(1); _Pragma("unroll") for (int m = 0; m < 4; ++m) _Pragma("unroll") for (int n = 0; n < 2; ++n) _Pragma("unroll") for (int k = 0; k < 2; ++k) \
        acc[ai][bj][m][n] = __builtin_amdgcn_mfma_f32_16x16x32_bf16(Bt[n][k], At[m][k], acc[ai][bj][m][n], 0, 0, 0); __builtin_amdgcn_s_setprio(0); } while (0)
#define PG8_WAIT_V(n) asm volatile("s_waitcnt vmcnt(" #n ")" ::: "memory")
#define PG8_WAIT_L(n) asm volatile("s_waitcnt lgkmcnt(" #n ")" ::: "memory")
#define PG8_BAR __builtin_amdgcn_s_barrier()
#define PG8_SCHED __builtin_amdgcn_sched_barrier(0)
    Unit cur, nxt; int ui = 0;
    if (!S.next(0, cur)) return;
    f32x4 acc[2][2][4][2];
#pragma unroll
    for (int a = 0; a < 2; ++a)
#pragma unroll
        for (int b = 0; b < 2; ++b)
#pragma unroll
            for (int m = 0; m < 4; ++m)
#pragma unroll
                for (int n = 0; n < 2; ++n) acc[a][b][m][n] = (f32x4){0.f, 0.f, 0.f, 0.f};
    bf16x8 At[4][2], B0[2][2], B1[2][2];
    const char* cA = (const char*)g.A + (size_t)cur.pm * tstep; const char* cB = (const char*)g.Bt + (size_t)cur.pn * tstep;
    S.a_ready(cur);
    if constexpr (SP2) {
        PG8_STAGE(PG8_SB(0, 0), cB, voffB); PG8_STAGE(PG8_SB(0, 1), cB + hstep, voffB); PG8_STAGE(PG8_SA(0, 0), cA, voffA); PG8_STAGE(PG8_SA(0, 1), cA + hstep, voffA);
        if (wr == 1) PG8_BAR;
        PG8_WAIT_V(2); PG8_BAR;
        PG8_STAGE(PG8_SB(1, 0), cB + kstep, voffB); PG8_STAGE(PG8_SA(1, 0), cA + kstep, voffA); PG8_STAGE(PG8_SB(1, 1), cB + hstep + kstep, voffB);
        PG8_WAIT_V(6); PG8_BAR;
    } else {
        PG8_STAGE(PG8_SB(0, 0), cB, voffB); PG8_STAGE(PG8_SA(0, 0), cA, voffA); PG8_STAGE(PG8_SB(0, 1), cB + hstep, voffB); PG8_STAGE(PG8_SA(0, 1), cA + hstep, voffA);
        if (wr == 1) PG8_BAR;
        PG8_WAIT_V(4); PG8_BAR;
        PG8_STAGE(PG8_SB(1, 0), cB + kstep, voffB); PG8_STAGE(PG8_SA(1, 0), cA + kstep, voffA); PG8_STAGE(PG8_SB(1, 1), cB + hstep + kstep, voffB);
        PG8_WAIT_V(6); PG8_BAR;
    }
    for (;;) {
        const bool has_next = S.next(ui + 1, nxt);
        const char* nA = has_next ? (const char*)g.A + (size_t)nxt.pm * tstep : cA; const char* nB = has_next ? (const char*)g.Bt + (size_t)nxt.pn * tstep : cB;
        for (int t = 0; t < nt; t += 2) {
            const bool last = (t == nt - 2);
            const char* a1 = cA + (size_t)(t + 1) * kstep;
            const char* a2 = last ? nA : cA + (size_t)(t + 2) * kstep; const char* b2 = last ? nB : cB + (size_t)(t + 2) * kstep;
            const char* a3 = a2 + kstep; const char* b3 = b2 + kstep;
            if (last && has_next) S.a_ready(nxt);
            if constexpr (SP2) {
            PG8_LDB(B0, 0, 0); PG8_LDB(B1, 0, 1); PG8_SCHED; PG8_LDA(At, 0, 0); PG8_STAGE(PG8_SA(1, 1), a1 + hstep, voffA);
            PG8_WAIT_V(8); PG8_WAIT_L(0); PG8_BAR; PG8_MMA(0, 0, At, B0); PG8_MMA(0, 1, At, B1); PG8_BAR; PG8_SCHED;
            PG8_LDA(At, 0, 1); PG8_STAGE(PG8_SB(0, 0), b2, voffB); PG8_STAGE(PG8_SB(0, 1), b2 + hstep, voffB); PG8_STAGE(PG8_SA(0, 0), a2, voffA);
            PG8_WAIT_V(8); PG8_WAIT_L(0); PG8_BAR; PG8_MMA(1, 0, At, B0); PG8_MMA(1, 1, At, B1); PG8_BAR; PG8_SCHED;
            PG8_LDB(B0, 1, 0); PG8_LDB(B1, 1, 1); PG8_SCHED; PG8_LDA(At, 1, 0); PG8_STAGE(PG8_SA(0, 1), a2 + hstep, voffA);
            PG8_WAIT_V(8); PG8_WAIT_L(0); PG8_BAR; PG8_MMA(0, 0, At, B0); PG8_MMA(0, 1, At, B1); PG8_BAR; PG8_SCHED;
            PG8_LDA(At, 1, 1); PG8_STAGE(PG8_SB(1, 0), b3, voffB); PG8_STAGE(PG8_SB(1, 1), b3 + hstep, voffB); PG8_STAGE(PG8_SA(1, 0), a3, voffA);
            PG8_WAIT_V(8); PG8_WAIT_L(0); PG8_BAR; PG8_MMA(1, 0, At, B0); PG8_MMA(1, 1, At, B1); PG8_BAR; PG8_SCHED;
            } else {
            PG8_LDB(B0, 0, 0); PG8_SCHED; PG8_LDA(At, 0, 0); PG8_STAGE(PG8_SA(1, 1), a1 + hstep, voffA);
            PG8_WAIT_L(8); PG8_BAR; PG8_WAIT_L(0); PG8_MMA(0, 0, At, B0); PG8_BAR; PG8_SCHED;
            PG8_LDB(B1, 0, 1); PG8_STAGE(PG8_SB(0, 0), b2, voffB);
            PG8_BAR; PG8_WAIT_L(0); PG8_MMA(0, 1, At, B1); PG8_BAR;
            PG8_LDA(At, 0, 1); PG8_STAGE(PG8_SA(0, 0), a2, voffA);
            PG8_BAR; PG8_WAIT_L(0); PG8_MMA(1, 0, At, B0); PG8_BAR; PG8_SCHED;
            PG8_STAGE(PG8_SB(0, 1), b2 + hstep, voffB);
            PG8_WAIT_V(6); PG8_BAR; PG8_MMA(1, 1, At, B1); PG8_BAR;
            PG8_LDB(B0, 1, 0); PG8_SCHED; PG8_LDA(At, 1, 0); PG8_STAGE(PG8_SA(0, 1), a2 + hstep, voffA);
            PG8_WAIT_L(8); PG8_BAR; PG8_WAIT_L(0); PG8_MMA(0, 0, At, B0); PG8_BAR; PG8_SCHED;
            PG8_LDB(B1, 1, 1); PG8_STAGE(PG8_SB(1, 0), b3, voffB);
            PG8_BAR; PG8_WAIT_L(0); PG8_MMA(0, 1, At, B1); PG8_BAR;
            PG8_LDA(At, 1, 1); PG8_STAGE(PG8_SA(1, 0), a3, voffA);
            PG8_BAR; PG8_WAIT_L(0); PG8_MMA(1, 0, At, B0); PG8_BAR; PG8_SCHED;
            PG8_STAGE(PG8_SB(1, 1), b3 + hstep, voffB);
            PG8_WAIT_V(6); PG8_BAR; PG8_MMA(1, 1, At, B1); PG8_BAR;
            }
        }
        if constexpr (ALIGN_EPI) { if (wr == 0) PG8_BAR; }
        if constexpr (!Epi::AFTER_DRAIN) { E(acc, cur, wr, wc, fr, fq); S.done(cur); }
        if (!has_next) break;
#pragma unroll
        for (int a = 0; a < 2; ++a)
#pragma unroll
            for (int b = 0; b < 2; ++b)
#pragma unroll
                for (int m = 0; m < 4; ++m)
#pragma unroll
                    for (int n = 0; n < 2; ++n) acc[a][b][m][n] = (f32x4){0.f, 0.f, 0.f, 0.f};
        cur = nxt; cA = nA; cB = nB; ++ui;
        if constexpr (ALIGN_EPI) { if (wr == 1) PG8_BAR; }
    }
    PG8_WAIT_V(0);
    if constexpr (!ALIGN_EPI) { if (wr == 0) PG8_BAR; }
    PG8_BAR;
    if constexpr (Epi::AFTER_DRAIN) { E.fused(acc, cur, wr, wc, fr, fq, lds, wid, lane); S.done(cur); }
#undef PG8_SA
#undef PG8_SB
#undef PG8_STAGE
#undef PG8_LDA
#undef PG8_LDB
#undef PG8_MMA
#undef PG8_WAIT_V
#undef PG8_WAIT_L
#undef PG8_BAR
#undef PG8_SCHED
}
}
constexpr int DM = 1024, NB = 4, SEQ = 4096, NMETA = 16, LT = SEQ + NMETA  , T = NB * LT  , MP = 16640  , DEPTH = 4;
constexpr int RWCOLS = 1824, INCOLS = 5408, FFH = 2816, NH = 8;
constexpr float RMS_EPS = 1e-6f, GN_EPS = 64e-5f;
constexpr float C2 = 0.125f * 1.4426950408889634f;
constexpr int NWAVES = 8, NTHREADS = 512;

#define LAS __attribute__((address_space(3)))
typedef unsigned short bf16_t;
typedef short bf16x8 __attribute__((ext_vector_type(8)));
typedef short s16x4 __attribute__((ext_vector_type(4)));
typedef float f32x4 __attribute__((ext_vector_type(4)));
typedef float f32x16 __attribute__((ext_vector_type(16)));
typedef unsigned u32x4 __attribute__((ext_vector_type(4)));
typedef unsigned u32x2 __attribute__((ext_vector_type(2)));
typedef float f32x2_t __attribute__((ext_vector_type(2))); typedef __bf16 bf16x2_t __attribute__((ext_vector_type(2)));
__device__ __forceinline__ unsigned cvt_pk_bf16(float lo, float hi) { f32x2_t v = {lo, hi}; bf16x2_t b = __builtin_convertvector(v, bf16x2_t); return __builtin_bit_cast(unsigned, b); }

constexpr size_t al256(size_t x) { return (x + 255) & ~(size_t)255; }
constexpr size_t OFF_SSQ = 0;
constexpr size_t OFF_BONUS = al256(OFF_SSQ + (size_t)2 * MP * 16 * 4);
constexpr size_t OFF_W1A = al256(OFF_BONUS + (size_t)T * 8 * 4);
constexpr size_t OFF_WV = OFF_W1A + (size_t)3072 * 1024 * 2;
constexpr size_t OFF_WG = OFF_WV + (size_t)512 * 1024 * 2;
constexpr size_t OFF_WL = OFF_WG + (size_t)2048 * 1024 * 2;
constexpr size_t OFF_WSB = OFF_WL + (size_t)2048 * 384 * 2;
constexpr size_t OFF_WRW = OFF_WSB + (size_t)1024 * 512 * 2;
constexpr size_t OFF_WO = OFF_WRW + (size_t)1024 * 512 * 2;
constexpr size_t OFF_H = OFF_WO + (size_t)1024 * 1024 * 2;
constexpr size_t OFF_HB = OFF_H + (size_t)MP * 1024 * 4;
constexpr size_t OFF_VFIRST = OFF_HB + (size_t)MP * 1024 * 2;
constexpr size_t OFF_E = al256(OFF_VFIRST + (size_t)T * 512 * 2);
constexpr size_t OFF_F = OFF_E + (size_t)MP * 2048 * 2;
constexpr size_t OFF_G = OFF_F + (size_t)MP * 2048 * 2;
constexpr size_t OFF_WF1 = OFF_H;
constexpr size_t OFF_WF2 = OFF_WF1 + (size_t)5632 * 1024 * 2;
constexpr size_t OFF_HH = OFF_G + (size_t)MP * 1024 * 2;
constexpr size_t OFF_I = OFF_HH + (size_t)512 * MP * 2;
constexpr size_t OFF_J = OFF_I + (size_t)MP * 512 * 2;
constexpr size_t OFF_BAR = al256(OFF_J + (size_t)MP * 512 * 2);
constexpr size_t WS_END = OFF_BAR + 16384;
static_assert(WS_END <= (size_t)369098752, "workspace map exceeds 4x the largest input tensor");
static_assert((size_t)MP * 2816 * 2 <= 2 * (size_t)MP * 2048 * 2, "HID fits E+F");

constexpr int LDS_BYTES = 147456;

__device__ __forceinline__ float bf2f(bf16_t v) { return __uint_as_float((unsigned)v << 16); }
__device__ __forceinline__ float bflo(unsigned w) { return __uint_as_float(w << 16); }
__device__ __forceinline__ float bfhi(unsigned w) { return __uint_as_float(w & 0xffff0000u); }
__device__ __forceinline__ bf16_t f2bf(float f) { return (bf16_t)(cvt_pk_bf16(f, 0.f) & 0xffffu); }
__device__ __forceinline__ int opq(int v) { asm volatile("" : "+v"(v)); return v; }
template <int CTRL, int ROWMASK> __device__ __forceinline__ float dpp0(float v) { return __builtin_bit_cast(float, __builtin_amdgcn_update_dpp(0, __builtin_bit_cast(int, v), CTRL, ROWMASK, 0xF, false)); }
__device__ __forceinline__ float wave_sum(float v) {
    v += dpp0<0xB1, 0xF>(v);
    v += dpp0<0x4E, 0xF>(v);
    v += dpp0<0x141, 0xF>(v);
    v += dpp0<0x140, 0xF>(v);
    v += dpp0<0x142, 0xA>(v);
    v += dpp0<0x143, 0xC>(v);
    return __builtin_bit_cast(float, __builtin_amdgcn_readlane(__builtin_bit_cast(int, v), 63));
}
__device__ __forceinline__ float row_rstd(const float* part, int row) {
    const f32x4* p = (const f32x4*)(part + (size_t)row * 16);
    const f32x4 a = p[0], b = p[1], c = p[2], d = p[3];
    const float s = ((a[0] + a[1]) + (a[2] + a[3])) + ((b[0] + b[1]) + (b[2] + b[3])) + (((c[0] + c[1]) + (c[2] + c[3])) + ((d[0] + d[1]) + (d[2] + d[3])));
    return rsqrtf(s * (1.f / 1024.f) + RMS_EPS);
}
__device__ __forceinline__ float fexp(float x) { return __builtin_amdgcn_exp2f(1.4426950408889634f * x); }
__device__ __forceinline__ float fsigmoid(float x) { return __builtin_amdgcn_rcpf(1.f + __builtin_amdgcn_exp2f(-1.4426950408889634f * x)); }
__device__ __forceinline__ float fsoftplus(float x) { return fmaxf(x, 0.f) + 0.6931471805599453f * __builtin_amdgcn_logf(1.f + __builtin_amdgcn_exp2f(-1.4426950408889634f * fabsf(x))); }

template <int ACT, bool HAS_SSQ> struct EpiStore {
    static constexpr bool PERM = true, AFTER_DRAIN = false;
    bf16_t* O0; int ld0; bf16_t* O1; int ld1; int split; const float* ssq; float scale0; int n0;
    __device__ __forceinline__ void operator()(const f32x4 (&acc)[2][2][4][2], const pg8::Unit& u, int wr, int wc, int fr, int fq) const {
        bf16_t* base; int ld, colt;
        if (u.pn < split) { base = O0; ld = ld0; colt = u.pn * 256; } else { base = O1; ld = ld1; colt = (u.pn - split) * 256; }
        const float sc = (u.pn < n0) ? scale0 : 1.f;
        const int row0 = u.pm * 256 + wr * 64 + fr;
        unsigned off = (unsigned)row0 * (unsigned)ld + (unsigned)(colt + wc * 32 + 8 * fq);
#pragma unroll
        for (int ai = 0; ai < 2; ++ai) {
#pragma unroll
            for (int m = 0; m < 4; ++m) {
                float rs = sc; if (HAS_SSQ) rs *= row_rstd(ssq, row0 + ai * 128 + m * 16);
#pragma unroll
                for (int bj = 0; bj < 2; ++bj) {
                    f32x4 v0 = acc[ai][bj][m][0] * rs, v1 = acc[ai][bj][m][1] * rs;
                    if (ACT) {
#pragma unroll
                        for (int e = 0; e < 4; ++e) { v0[e] = fsigmoid(v0[e]); v1[e] = fsigmoid(v1[e]); }
                    }
                    u32x4 w; w.x = cvt_pk_bf16(v0[0], v0[1]); w.y = cvt_pk_bf16(v0[2], v0[3]); w.z = cvt_pk_bf16(v1[0], v1[1]); w.w = cvt_pk_bf16(v1[2], v1[3]);
                    *(u32x4*)(base + off + bj * 128) = w;
                }
                off += 16u * (unsigned)ld;
                asm volatile("" ::: "memory");
            }
            off += 64u * (unsigned)ld;
        }
    }
};
struct EpiVT {
    static constexpr bool PERM = true, AFTER_DRAIN = false;
    bf16_t* O; int ld; const float* ssq;
    __device__ __forceinline__ void operator()(const f32x4 (&acc)[2][2][4][2], const pg8::Unit& u, int wr, int wc, int fr, int fq) const {
        const int row0 = u.pm * 256 + wr * 64 + fr, col0 = u.pn * 256 + wc * 32 + 8 * fq;
        f32x4 rs[2][2];
#pragma unroll
        for (int bj = 0; bj < 2; ++bj)
#pragma unroll
            for (int n = 0; n < 2; ++n)
#pragma unroll
                for (int e = 0; e < 4; ++e) rs[bj][n][e] = row_rstd(ssq, col0 + bj * 128 + 4 * n + e);
#pragma unroll
        for (int ai = 0; ai < 2; ++ai)
#pragma unroll
            for (int m = 0; m < 4; ++m) {
                bf16_t* rowp = O + (size_t)(row0 + ai * 128 + m * 16) * ld + col0;
#pragma unroll
                for (int bj = 0; bj < 2; ++bj) {
                    const f32x4 v0 = acc[ai][bj][m][0] * rs[bj][0], v1 = acc[ai][bj][m][1] * rs[bj][1];
                    u32x4 w; w.x = cvt_pk_bf16(v0[0], v0[1]); w.y = cvt_pk_bf16(v0[2], v0[3]); w.z = cvt_pk_bf16(v1[0], v1[1]); w.w = cvt_pk_bf16(v1[2], v1[3]);
                    *(u32x4*)(rowp + bj * 128) = w;
                }
            }
    }
};
struct EpiGateMul {
    static constexpr bool PERM = true, AFTER_DRAIN = false;
    bf16_t* O; const bf16_t* gate; int ldg; int gcol; int accum;
    __device__ __forceinline__ void operator()(const f32x4 (&acc)[2][2][4][2], const pg8::Unit& u, int wr, int wc, int fr, int fq) const {
        const int row0 = u.pm * 256 + wr * 64 + fr, col0 = u.pn * 256 + wc * 32 + 8 * fq;
#pragma unroll
        for (int ai = 0; ai < 2; ++ai)
#pragma unroll
            for (int m = 0; m < 4; ++m) {
                const int row = row0 + ai * 128 + m * 16;
#pragma unroll
                for (int bj = 0; bj < 2; ++bj) {
                    const int col = col0 + bj * 128;
                    const u32x4 g = *(const u32x4*)(gate + (size_t)row * ldg + gcol + col);
                    bf16_t* op = O + (size_t)row * 1024 + col;
                    u32x4 p = (u32x4){0u, 0u, 0u, 0u}; if (accum) p = *(const u32x4*)op;
                    const f32x4 a0 = acc[ai][bj][m][0], a1 = acc[ai][bj][m][1];
                    u32x4 w;
                    w.x = cvt_pk_bf16(bflo(g.x) * a0[0] + bflo(p.x), bfhi(g.x) * a0[1] + bfhi(p.x));
                    w.y = cvt_pk_bf16(bflo(g.y) * a0[2] + bflo(p.y), bfhi(g.y) * a0[3] + bfhi(p.y));
                    w.z = cvt_pk_bf16(bflo(g.z) * a1[0] + bflo(p.z), bfhi(g.z) * a1[1] + bfhi(p.z));
                    w.w = cvt_pk_bf16(bflo(g.w) * a1[2] + bflo(p.w), bfhi(g.w) * a1[3] + bfhi(p.w));
                    *(u32x4*)op = w;
                }
            }
    }
};
struct EpiResid {
    static constexpr bool PERM = true, AFTER_DRAIN = false;
    bf16_t* HB; float* ssq_next;
    __device__ __forceinline__ void operator()(const f32x4 (&acc)[2][2][4][2], const pg8::Unit& u, int wr, int wc, int fr, int fq) const {
        const int row0 = u.pm * 256 + wr * 64 + fr, col0 = u.pn * 256 + wc * 32 + 8 * fq;
#pragma unroll
        for (int ai = 0; ai < 2; ++ai)
#pragma unroll
            for (int m = 0; m < 4; ++m) {
                const int row = row0 + ai * 128 + m * 16; float ss = 0.f;
#pragma unroll
                for (int bj = 0; bj < 2; ++bj) {
                    bf16_t* hp = HB + (size_t)row * 1024 + col0 + bj * 128;
                    const u32x4 hb = *(const u32x4*)hp;
                    f32x4 h0 = (f32x4){bflo(hb.x), bfhi(hb.x), bflo(hb.y), bfhi(hb.y)}, h1 = (f32x4){bflo(hb.z), bfhi(hb.z), bflo(hb.w), bfhi(hb.w)};
                    h0 += acc[ai][bj][m][0]; h1 += acc[ai][bj][m][1];
                    u32x4 w; w.x = cvt_pk_bf16(h0[0], h0[1]); w.y = cvt_pk_bf16(h0[2], h0[3]); w.z = cvt_pk_bf16(h1[0], h1[1]); w.w = cvt_pk_bf16(h1[2], h1[3]);
                    *(u32x4*)hp = w;
                    ss += (h0[0] * h0[0] + h0[1] * h0[1]) + (h0[2] * h0[2] + h0[3] * h0[3]) + (h1[0] * h1[0] + h1[1] * h1[1]) + (h1[2] * h1[2] + h1[3] * h1[3]);
                }
                ss += __shfl_xor(ss, 16); ss += __shfl_xor(ss, 32);
                if (fq == 0) ssq_next[(size_t)row * 16 + u.pn * 4 + wc] = ss;
            }
    }
};
struct EpiSwiglu {
    static constexpr bool PERM = true, AFTER_DRAIN = false;
    bf16_t* O; const float* ssq;
    __device__ __forceinline__ void operator()(const f32x4 (&acc)[2][2][4][2], const pg8::Unit& u, int wr, int wc, int fr, int fq) const {
        const int row0 = u.pm * 256 + wr * 64 + fr, hcol0 = u.pn * 128 + wc * 16 + 4 * fq;
#pragma unroll
        for (int ai = 0; ai < 2; ++ai)
#pragma unroll
            for (int m = 0; m < 4; ++m) {
                const int row = row0 + ai * 128 + m * 16;
                const float rs = row_rstd(ssq, row);
#pragma unroll
                for (int bj = 0; bj < 2; ++bj) {
                    const f32x4 g = acc[ai][bj][m][0] * rs, up = acc[ai][bj][m][1] * rs;
                    float hv[4];
#pragma unroll
                    for (int e = 0; e < 4; ++e) hv[e] = g[e] * fsigmoid(g[e]) * up[e];
                    u32x2 w; w.x = cvt_pk_bf16(hv[0], hv[1]); w.y = cvt_pk_bf16(hv[2], hv[3]);
                    *(u32x2*)(O + (size_t)row * FFH + hcol0 + bj * 64) = w;
                }
            }
    }
};


constexpr int MB = 16384;
struct TStoreP { bf16_t* O0; int ld0; bf16_t* O1; int ld1; int split_col; const float* ssq; float scale0; int n0_col; };
template <int ACT, bool HAS_SSQ> struct TStore { TStoreP p;
    __device__ __forceinline__ void operator()(int row, int col0, const float (&v)[8], int) const {
        bf16_t* base; int ld, col;
        if (col0 < p.split_col) { base = p.O0; ld = p.ld0; col = col0; } else { base = p.O1; ld = p.ld1; col = col0 - p.split_col; }
        float rs = (col0 < p.n0_col) ? p.scale0 : 1.f; if (HAS_SSQ) rs *= row_rstd(p.ssq, row);
        float o[8];
#pragma unroll
        for (int e = 0; e < 8; ++e) { o[e] = v[e] * rs; if (ACT) o[e] = fsigmoid(o[e]); }
        u32x4 w; w.x = cvt_pk_bf16(o[0], o[1]); w.y = cvt_pk_bf16(o[2], o[3]); w.z = cvt_pk_bf16(o[4], o[5]); w.w = cvt_pk_bf16(o[6], o[7]);
        *(u32x4*)(base + (size_t)row * ld + col) = w;
    } };
struct TVT { bf16_t* O; int ld; const float* ssq;
    __device__ __forceinline__ void operator()(int row, int col0, const float (&v)[8], int) const {
        const float rs = row_rstd(ssq, row);
#pragma unroll
        for (int e = 0; e < 8; ++e) O[(size_t)(col0 + e) * ld + row] = f2bf(v[e] * rs);
    } };
struct TGateMul { bf16_t* O; const bf16_t* gate; int ldg; int gcol; int accum;
    __device__ __forceinline__ void operator()(int row, int col0, const float (&v)[8], int) const {
        const u32x4 g = *(const u32x4*)(gate + (size_t)row * ldg + gcol + col0); bf16_t* op = O + (size_t)row * 1024 + col0;
        u32x4 p = (u32x4){0u, 0u, 0u, 0u}; if (accum) p = *(const u32x4*)op;
        u32x4 w;
        w.x = cvt_pk_bf16(bflo(g.x) * v[0] + bflo(p.x), bfhi(g.x) * v[1] + bfhi(p.x)); w.y = cvt_pk_bf16(bflo(g.y) * v[2] + bflo(p.y), bfhi(g.y) * v[3] + bfhi(p.y));
        w.z = cvt_pk_bf16(bflo(g.z) * v[4] + bflo(p.z), bfhi(g.z) * v[5] + bfhi(p.z)); w.w = cvt_pk_bf16(bflo(g.w) * v[6] + bflo(p.w), bfhi(g.w) * v[7] + bfhi(p.w));
        *(u32x4*)op = w;
    } };
struct TResid { bf16_t* HB; float* ssq_next;
    __device__ __forceinline__ void operator()(int row, int col0, const float (&v)[8], int unit) const {
        bf16_t* hp = HB + (size_t)row * 1024 + col0; const u32x4 hb = *(const u32x4*)hp;
        f32x4 h0 = (f32x4){bflo(hb.x), bfhi(hb.x), bflo(hb.y), bfhi(hb.y)}, h1 = (f32x4){bflo(hb.z), bfhi(hb.z), bflo(hb.w), bfhi(hb.w)};
        h0 += (f32x4){v[0], v[1], v[2], v[3]}; h1 += (f32x4){v[4], v[5], v[6], v[7]};
        u32x4 w; w.x = cvt_pk_bf16(h0[0], h0[1]); w.y = cvt_pk_bf16(h0[2], h0[3]); w.z = cvt_pk_bf16(h1[0], h1[1]); w.w = cvt_pk_bf16(h1[2], h1[3]);
        *(u32x4*)hp = w;
        float ss = (h0[0] * h0[0] + h0[1] * h0[1]) + (h0[2] * h0[2] + h0[3] * h0[3]) + (h1[0] * h1[0] + h1[1] * h1[1]) + (h1[2] * h1[2] + h1[3] * h1[3]);
        ss += __shfl_xor(ss, 1); ss += __shfl_xor(ss, 2); ss += __shfl_xor(ss, 4);
        if ((col0 & 63) == 0) ssq_next[(size_t)row * 16 + unit] = ss;
    } };
struct TSwiglu { bf16_t* O; const float* ssq;
    __device__ __forceinline__ void operator()(int row, int col0, const float (&v)[8], int) const {
        const float rs = row_rstd(ssq, row); float hv[4];
#pragma unroll
        for (int e = 0; e < 4; ++e) { const float g = v[e] * rs, up = v[4 + e] * rs; hv[e] = g * fsigmoid(g) * up; }
        u32x2 w; w.x = cvt_pk_bf16(hv[0], hv[1]); w.y = cvt_pk_bf16(hv[2], hv[3]);
        *(u32x2*)(O + (size_t)row * FFH + (col0 >> 1)) = w;
    } };
template <class TE> __device__ __forceinline__ void tail_gemm(LAS unsigned char* lds, const bf16_t* A, const bf16_t* Bt, int K, int N, const TE& E, int wave, int lane, int boff = 0) {
    const int r32 = lane & 31, hi = lane >> 5, kw = K >> 3, k0 = wave * kw, tid = opq((int)threadIdx.x);
    if (boff >= (int)gridDim.x) boff = 0;
    LAS float* P = (LAS float*)lds;
    for (int unit = (int)blockIdx.x >= boff ? (int)blockIdx.x - boff : (int)blockIdx.x + (int)gridDim.x - boff; unit < (N >> 6); unit += gridDim.x) {
        f32x16 acc[2][2];
#pragma unroll
        for (int i = 0; i < 2; ++i)
#pragma unroll
            for (int j = 0; j < 2; ++j)
#pragma unroll
                for (int r = 0; r < 16; ++r) acc[i][j][r] = 0.f;
        const bf16_t* ap = A + (size_t)r32 * K + k0 + hi * 8;
        const bf16_t* bp = Bt + (size_t)(unit * 64 + r32) * K + k0 + hi * 8;
#pragma unroll 4
        for (int ks = 0; ks < kw; ks += 16) {
            const bf16x8 a0 = *(const bf16x8*)(ap + ks), a1 = *(const bf16x8*)(ap + (size_t)32 * K + ks), b0 = *(const bf16x8*)(bp + ks), b1 = *(const bf16x8*)(bp + (size_t)32 * K + ks);
            acc[0][0] = __builtin_amdgcn_mfma_f32_32x32x16_bf16(a0, b0, acc[0][0], 0, 0, 0); acc[0][1] = __builtin_amdgcn_mfma_f32_32x32x16_bf16(a0, b1, acc[0][1], 0, 0, 0);
            acc[1][0] = __builtin_amdgcn_mfma_f32_32x32x16_bf16(a1, b0, acc[1][0], 0, 0, 0); acc[1][1] = __builtin_amdgcn_mfma_f32_32x32x16_bf16(a1, b1, acc[1][1], 0, 0, 0);
        }
#pragma unroll
        for (int i = 0; i < 2; ++i)
#pragma unroll
            for (int j = 0; j < 2; ++j)
#pragma unroll
                for (int r = 0; r < 16; ++r) P[(wave * 64 + 32 * i + (r & 3) + 8 * (r >> 2) + 4 * hi) * 64 + 32 * j + r32] = acc[i][j][r];
        __syncthreads();
        const int row = tid >> 3, cgp = tid & 7; float v[8];
#pragma unroll
        for (int e = 0; e < 8; ++e) v[e] = 0.f;
#pragma unroll
        for (int w = 0; w < 8; ++w) { const f32x4 p0 = *(const LAS f32x4*)(P + (w * 64 + row) * 64 + cgp * 8), p1 = *(const LAS f32x4*)(P + (w * 64 + row) * 64 + cgp * 8 + 4);
            v[0] += p0[0]; v[1] += p0[1]; v[2] += p0[2]; v[3] += p0[3]; v[4] += p1[0]; v[5] += p1[1]; v[6] += p1[2]; v[7] += p1[3]; }
        E(MB + row, unit * 64 + cgp * 8, v, unit);
        __syncthreads();
    }
}

struct Args { const float* in[26]; float* out; unsigned char* ws; };
typedef const __attribute__((address_space(4))) Args* CArgs;
__device__ __forceinline__ CArgs opq_args(CArgs p) { asm volatile("" : "+s"(p)); return p; }
enum { I_X = 0, I_META, I_NMIX, I_NFFN, I_NFIN, I_WIN, I_MURW, I_W0, I_WUP, I_A0, I_AUP, I_GUP, I_KK, I_KA, I_RK, I_LNW, I_LNB, I_VDOWN, I_VMU, I_VUP, I_VRES0, I_WSB, I_WRW, I_WOUT, I_WF1, I_WF2 };

__device__ __forceinline__ void tr_item(const float* W, int ldw, int c0, int nblk, int item, bf16_t* D, int ldd, int r0, int mode, const float* gain, LAS float* scr, int lane) {
    const int kb = item / nblk, nb = item % nblk, k0 = 64 * kb, n0 = 32 * nb;
    float tv[32];
#pragma unroll
    for (int i = 0; i < 32; ++i) tv[i] = W[(size_t)(k0 + 2 * i + (lane >> 5)) * ldw + c0 + n0 + (lane & 31)];
#pragma unroll
    for (int i = 0; i < 32; ++i) { const int kk = 2 * i + (lane >> 5); float v = tv[i]; if (gain) v *= gain[k0 + kk]; scr[kk * 33 + (lane & 31)] = v; }
    asm volatile("s_waitcnt lgkmcnt(0)" ::: "memory");
    const int c = lane & 7;
#pragma unroll
    for (int j = 0; j < 4; ++j) {
        const int n = (lane >> 3) + 8 * j; const LAS float* s = scr + (8 * c) * 33 + n;
        u32x4 o; o.x = cvt_pk_bf16(s[0 * 33], s[1 * 33]); o.y = cvt_pk_bf16(s[2 * 33], s[3 * 33]); o.z = cvt_pk_bf16(s[4 * 33], s[5 * 33]); o.w = cvt_pk_bf16(s[6 * 33], s[7 * 33]);
        int drow;
        if (mode == 0) drow = r0 + n0 + n;
        else { const int col = c0 + n0 + n, isup = col >= FFH ? 1 : 0, jj = col - isup * FFH; drow = 8 * (jj >> 2) + 4 * isup + (jj & 3); }
        *(u32x4*)(D + (size_t)drow * ldd + k0 + 8 * c) = o;
    }
    asm volatile("s_waitcnt lgkmcnt(0)" ::: "memory");
}
__device__ __forceinline__ void tr_job(const float* W, int K, int ldw, int c0, int ncols, bf16_t* D, int ldd, int r0, int mode, const float* gain, LAS float* scr, int lane, int gw, int ngw) {
    const int nblk = ncols / 32, nitems = (K / 64) * nblk;
    for (int it = gw; it < nitems; it += ngw) tr_item(W, ldw, c0, nblk, it, D, ldd, r0, mode, gain, scr, lane);
}
__device__ __forceinline__ void zero16(void* p, size_t bytes, int gtid, int ngt) {
    u32x4* q = (u32x4*)p; const size_t n = bytes / 16;
    for (size_t i = gtid; i < n; i += ngt) q[i] = (u32x4){0u, 0u, 0u, 0u};
}
__device__ __forceinline__ void convert_mix_weights(CArgs a, int l, LAS unsigned char* lds, int wave, int lane, int gw, int ngw) {
    unsigned char* ws = a->ws;
    LAS float* scr = (LAS float*)(lds + wave * 8448);
    const float* win = a->in[I_WIN] + (size_t)l * DM * INCOLS; const float* gmix = a->in[I_NMIX] + l * DM;
    bf16_t* W1A = (bf16_t*)(ws + OFF_W1A);
    tr_job(win, DM, INCOLS, 0, 1024, W1A, 1024, 0, 0, gmix, scr, lane, gw, ngw);
    tr_job(win, DM, INCOLS, 1536, RWCOLS, W1A, 1024, 1024, 0, gmix, scr, lane, gw, ngw);
    const int gtid = gw * 64 + lane, ngt = ngw * 64;
    if (l > 0) { tr_job(a->in[I_VDOWN] + (size_t)(l - 1) * DM * 32, DM, 32, 0, 32, W1A, 1024, 1024 + RWCOLS, 0, gmix, scr, lane, gw, ngw);
                 zero16(W1A + (size_t)(1024 + RWCOLS + 32) * 1024, (size_t)(3072 - 1024 - RWCOLS - 32) * 1024 * 2, gtid, ngt); }
    else zero16(W1A + (size_t)(1024 + RWCOLS) * 1024, (size_t)(3072 - 1024 - RWCOLS) * 1024 * 2, gtid, ngt);
    tr_job(win, DM, INCOLS, 1024, 512, (bf16_t*)(ws + OFF_WV), 1024, 0, 0, gmix, scr, lane, gw, ngw);
    tr_job(win, DM, INCOLS, 3360, 2048, (bf16_t*)(ws + OFF_WG), 1024, 0, 0, gmix, scr, lane, gw, ngw);
    tr_job(a->in[I_WSB] + (size_t)l * 512 * 1024, 512, 1024, 0, 1024, (bf16_t*)(ws + OFF_WSB), 512, 0, 0, nullptr, scr, lane, gw, ngw);
    tr_job(a->in[I_WRW] + (size_t)l * 512 * 1024, 512, 1024, 0, 1024, (bf16_t*)(ws + OFF_WRW), 512, 0, 0, nullptr, scr, lane, gw, ngw);
    tr_job(a->in[I_WOUT] + (size_t)l * 1024 * 1024, 1024, 1024, 0, 1024, (bf16_t*)(ws + OFF_WO), 1024, 0, 0, nullptr, scr, lane, gw, ngw);
    bf16_t* WL = (bf16_t*)(ws + OFF_WL);
    const float* wup = a->in[I_WUP] + (size_t)l * 64 * 512; const float* aup = a->in[I_AUP] + (size_t)l * 64 * 512; const float* gup = a->in[I_GUP] + (size_t)l * 160 * 512;
    const float* vup = a->in[I_VUP] + (size_t)(l > 0 ? l - 1 : 0) * 32 * 512;
    for (int idx = gtid; idx < 2048 * 384; idx += ngt) {
        const int n = idx / 384, k = idx - n * 384, grp = n >> 9, cn = n & 511; float v = 0.f;
        if (grp == 0) { if (k < 64) v = wup[k * 512 + cn]; }
        else if (grp == 1) { if (k >= 64 && k < 128) v = aup[(k - 64) * 512 + cn]; }
        else if (grp == 2) { if (k >= 128 && k < 288) v = gup[(k - 128) * 512 + cn]; }
        else { if (l > 0 && k >= 288 && k < 320) v = vup[(k - 288) * 512 + cn]; }
        WL[idx] = f2bf(v);
    }
}
__device__ __forceinline__ void convert_ffn_weights(CArgs a, int l, LAS unsigned char* lds, int wave, int lane, int gw, int ngw) {
    LAS float* scr = (LAS float*)(lds + wave * 8448);
    tr_job(a->in[I_WF1] + (size_t)l * DM * 2 * FFH, DM, 2 * FFH, 0, 2 * FFH, (bf16_t*)(a->ws + OFF_WF1), 1024, 0, 1, a->in[I_NFFN] + l * DM, scr, lane, gw, ngw);
    tr_job(a->in[I_WF2] + (size_t)l * FFH * DM, FFH, DM, 0, DM, (bf16_t*)(a->ws + OFF_WF2), FFH, 0, 0, nullptr, scr, lane, gw, ngw);
}

__device__ __forceinline__ void init_rows(CArgs a, int lane, int gw, int ngw) {
    bf16_t* HB = (bf16_t*)(a->ws + OFF_HB); float* ssq = (float*)(a->ws + OFF_SSQ);
    for (int row0 = gw; row0 < MP; row0 += 4 * ngw) {
        f32x4 v[4][4]; float s[4];
#pragma unroll
        for (int k = 0; k < 4; ++k) { const int row = row0 + k * ngw; s[k] = 0.f;
            if (row < T) { const int b = row / LT, t = row - b * LT;
                const float* src = t < NMETA ? a->in[I_META] + (size_t)t * DM : a->in[I_X] + ((size_t)b * SEQ + (t - NMETA)) * DM;
#pragma unroll
                for (int j = 0; j < 4; ++j) v[k][j] = *((const f32x4*)src + lane + 64 * j);
            } else {
#pragma unroll
                for (int j = 0; j < 4; ++j) v[k][j] = (f32x4){0.f, 0.f, 0.f, 0.f};
            } }
#pragma unroll
        for (int k = 0; k < 4; ++k) { const int row = row0 + k * ngw;
            if (row < MP) {
#pragma unroll
                for (int j = 0; j < 4; ++j) s[k] += (v[k][j].x * v[k][j].x + v[k][j].y * v[k][j].y) + (v[k][j].z * v[k][j].z + v[k][j].w * v[k][j].w);
                s[k] = wave_sum(s[k]);
#pragma unroll
                for (int j = 0; j < 4; ++j) {
                    u32x2 w; w.x = cvt_pk_bf16(v[k][j].x, v[k][j].y); w.y = cvt_pk_bf16(v[k][j].z, v[k][j].w); *((u32x2*)(HB + (size_t)row * DM) + lane + 64 * j) = w; }
                if (lane < 16) ssq[(size_t)row * 16 + lane] = lane == 0 ? s[k] : 0.f;
            } }
    }
}

__device__ __forceinline__ void sb_unit(const bf16_t* QK, const bf16_t* VT, bf16_t* YSB, int b, int h, int qb, int lane) {
    const int r32 = lane & 31, hi = lane >> 5, rowb = b * LT, q0 = qb * 32, tq = q0 + r32, tqc = tq < LT ? tq : LT - 1;
    bf16x8 qf[4];
    { const bf16_t* qp = QK + (size_t)(rowb + tqc) * 1024 + h * 64 + hi * 8;
#pragma unroll
      for (int s = 0; s < 4; ++s) qf[s] = *(const bf16x8*)(qp + s * 16); }
    bf16x8 lt[2];
#pragma unroll
    for (int ks = 0; ks < 2; ++ks)
#pragma unroll
        for (int i = 0; i < 8; ++i) lt[ks][i] = ((16 * ks + 4 * hi + (i & 3) + 8 * (i >> 2)) > r32) ? (short)0x3F80 : (short)0;
    f32x16 o0, o1;
#pragma unroll
    for (int r = 0; r < 16; ++r) { o0[r] = 0.f; o1[r] = 0.f; }
    float carry = 0.f;
    const bf16_t* vbase = VT + (size_t)(h * 64 + r32) * MP + rowb + 4 * hi;
#define SB_LOAD(kt_, KF, VLO, VHI) do { const int key0_ = (kt_) * 32; const int krow = (rowb + key0_ + r32) < T ? (rowb + key0_ + r32) : T - 1;     \
        const bf16_t* kp = QK + (size_t)krow * 1024 + 512 + h * 64 + hi * 8; \
        _Pragma("unroll") for (int s = 0; s < 4; ++s) KF[s] = *(const bf16x8*)(kp + s * 16); \
        _Pragma("unroll") for (int mt = 0; mt < 2; ++mt) _Pragma("unroll") for (int ks = 0; ks < 2; ++ks) { const int c0 = rowb + 4 * hi + key0_ + 16 * ks, c1 = c0 + 8; const bf16_t* vrow = VT + (size_t)(h * 64 + r32 + mt * 32) * MP; \
            VLO[mt][ks] = *(const s16x4*)(vrow + (c0 < T - 4 ? c0 : T - 4)); VHI[mt][ks] = *(const s16x4*)(vrow + (c1 < T - 4 ? c1 : T - 4)); } } while (0)
    bf16x8 kf[4]; s16x4 vlo[2][2], vhi[2][2];
    SB_LOAD(qb, kf, vlo, vhi);
    for (int kt = qb; kt >= 0; --kt) {
        const int key0 = kt * 32;
        bf16x8 kfn[4]; s16x4 vlon[2][2], vhin[2][2];
        SB_LOAD((kt > 0 ? kt - 1 : 0), kfn, vlon, vhin);
        bf16x8 vf[2][2];
#pragma unroll
        for (int mt = 0; mt < 2; ++mt)
#pragma unroll
            for (int ks = 0; ks < 2; ++ks) vf[mt][ks] = (bf16x8){vlo[mt][ks][0], vlo[mt][ks][1], vlo[mt][ks][2], vlo[mt][ks][3], vhi[mt][ks][0], vhi[mt][ks][1], vhi[mt][ks][2], vhi[mt][ks][3]};
        f32x16 st;
#pragma unroll
        for (int r = 0; r < 16; ++r) st[r] = 0.f;
#pragma unroll
        for (int s = 0; s < 4; ++s) st = __builtin_amdgcn_mfma_f32_32x32x16_bf16(kf[s], qf[s], st, 0, 0, 0);
        float sp[16]; float loc = 0.f;
#pragma unroll
        for (int r = 0; r < 16; ++r) {
            const int key = key0 + (r & 3) + 8 * (r >> 2) + 4 * hi;
            const float z = st[r];
            float v = fmaxf(z, 0.f) + __builtin_amdgcn_logf(1.f + __builtin_amdgcn_exp2f(-fabsf(z)));
            v = (key < tq) ? v : 0.f;
            sp[r] = v; loc += v;
        }
        u32x4 sb0, sb1;
        sb0.x = cvt_pk_bf16(sp[0], sp[1]); sb0.y = cvt_pk_bf16(sp[2], sp[3]); sb0.z = cvt_pk_bf16(sp[4], sp[5]); sb0.w = cvt_pk_bf16(sp[6], sp[7]);
        sb1.x = cvt_pk_bf16(sp[8], sp[9]); sb1.y = cvt_pk_bf16(sp[10], sp[11]); sb1.z = cvt_pk_bf16(sp[12], sp[13]); sb1.w = cvt_pk_bf16(sp[14], sp[15]);
        f32x16 bt;
#pragma unroll
        for (int r = 0; r < 16; ++r) bt[r] = carry;
        bt = __builtin_amdgcn_mfma_f32_32x32x16_bf16(lt[0], __builtin_bit_cast(bf16x8, sb0), bt, 0, 0, 0);
        bt = __builtin_amdgcn_mfma_f32_32x32x16_bf16(lt[1], __builtin_bit_cast(bf16x8, sb1), bt, 0, 0, 0);
        float p[16];
#pragma unroll
        for (int r = 0; r < 16; ++r) {
            const int key = key0 + (r & 3) + 8 * (r >> 2) + 4 * hi;
            const float la = st[r] - sp[r] - bt[r];
            p[r] = (key < tq) ? __builtin_amdgcn_exp2f(la) : 0.f;
        }
        u32x4 pb0, pb1;
        pb0.x = cvt_pk_bf16(p[0], p[1]); pb0.y = cvt_pk_bf16(p[2], p[3]); pb0.z = cvt_pk_bf16(p[4], p[5]); pb0.w = cvt_pk_bf16(p[6], p[7]);
        pb1.x = cvt_pk_bf16(p[8], p[9]); pb1.y = cvt_pk_bf16(p[10], p[11]); pb1.z = cvt_pk_bf16(p[12], p[13]); pb1.w = cvt_pk_bf16(p[14], p[15]);
        o0 = __builtin_amdgcn_mfma_f32_32x32x16_bf16(vf[0][0], __builtin_bit_cast(bf16x8, pb0), o0, 0, 0, 0);
        o0 = __builtin_amdgcn_mfma_f32_32x32x16_bf16(vf[0][1], __builtin_bit_cast(bf16x8, pb1), o0, 0, 0, 0);
        o1 = __builtin_amdgcn_mfma_f32_32x32x16_bf16(vf[1][0], __builtin_bit_cast(bf16x8, pb0), o1, 0, 0, 0);
        o1 = __builtin_amdgcn_mfma_f32_32x32x16_bf16(vf[1][1], __builtin_bit_cast(bf16x8, pb1), o1, 0, 0, 0);
        { const auto sw_ = __builtin_amdgcn_permlane32_swap(__float_as_uint(loc), __float_as_uint(loc), false, false); carry += __uint_as_float(sw_[0]) + __uint_as_float(sw_[1]); }
#pragma unroll
        for (int s = 0; s < 4; ++s) kf[s] = kfn[s];
#pragma unroll
        for (int mt = 0; mt < 2; ++mt)
#pragma unroll
            for (int ks = 0; ks < 2; ++ks) { vlo[mt][ks] = vlon[mt][ks]; vhi[mt][ks] = vhin[mt][ks]; }
        if (__all(carry > 170.f)) break;
    }
#undef SB_LOAD
    if (tq < LT) {
        bf16_t* op = YSB + (size_t)(rowb + tq) * 512 + h * 64 + 4 * hi;
#pragma unroll
        for (int rg = 0; rg < 4; ++rg) {
            u32x2 w0; w0.x = cvt_pk_bf16(o0[4 * rg], o0[4 * rg + 1]); w0.y = cvt_pk_bf16(o0[4 * rg + 2], o0[4 * rg + 3]);
            u32x2 w1; w1.x = cvt_pk_bf16(o1[4 * rg], o1[4 * rg + 1]); w1.y = cvt_pk_bf16(o1[4 * rg + 2], o1[4 * rg + 3]);
            *(u32x2*)(op + 8 * rg) = w0; *(u32x2*)(op + 32 + 8 * rg) = w1;
        }
    }
}

__device__ __forceinline__ void lora_act(CArgs a, int l, int lane, int gw, int ngw) {
    const bf16_t* RW = (const bf16_t*)(a->ws + OFF_E); bf16_t* A2 = (bf16_t*)(a->ws + OFF_I);
    float mu[5];
#pragma unroll
    for (int i = 0; i < 5; ++i) { const int col = lane + 64 * i; mu[i] = col < 288 ? a->in[I_MURW][l * RWCOLS + 1536 + col] : (l > 0 && col < 320 ? a->in[I_VMU][(l - 1) * 32 + col - 288] : 0.f); }
    for (int row0 = gw; row0 < T; row0 += 4 * ngw) {
        bf16_t ux[4][5], up[4][5]; float pm[4];
#pragma unroll
        for (int j = 0; j < 4; ++j) { const int row = row0 + j * ngw < T ? row0 + j * ngw : T - 1; const int t = row % LT;
            const bf16_t* cur = RW + (size_t)row * 2048 + 1536; const bf16_t* prv = t > 0 ? cur - 2048 : cur; pm[j] = t > 0 ? 1.f : 0.f;
#pragma unroll
            for (int i = 0; i < 5; ++i) { ux[j][i] = cur[lane + 64 * i]; up[j][i] = prv[lane + 64 * i]; } }
#pragma unroll
        for (int j = 0; j < 4; ++j) { const int row = row0 + j * ngw;
            if (row < T) {
#pragma unroll
                for (int i = 0; i < 6; ++i) {
                    const int col = lane + 64 * i; float v = 0.f;
                    if (i < 5) {
                        const float x = bf2f(ux[j][i]), xp = pm[j] * bf2f(up[j][i]);
                        const float s = x + (xp - x) * mu[i];
                        if (col < 64) v = 1.f - 2.f * __builtin_amdgcn_rcpf(fexp(2.f * s) + 1.f);
                        else if (col < 128) v = s;
                        else if (col < 288) v = fsigmoid(s);
                        else v = s;
                    }
                    A2[(size_t)row * 384 + col] = f2bf(v);
                }
            } }
    }
}

__device__ __forceinline__ void rw_finalise(CArgs a, int l, int lane, int gw, int ngw) {
    bf16_t* RW = (bf16_t*)(a->ws + OFF_E); bf16_t* LO = (bf16_t*)(a->ws + OFF_F); bf16_t* RFIN = (bf16_t*)(a->ws + OFF_I);
    bf16_t* VFIRST = (bf16_t*)(a->ws + OFF_VFIRST); bf16_t* VMIX = (bf16_t*)(a->ws + OFF_HH); float* BONUS = (float*)(a->ws + OFF_BONUS);
    const float* mu = a->in[I_MURW] + l * RWCOLS; const float* w0 = a->in[I_W0] + l * 512; const float* a0 = a->in[I_A0] + l * 512; const float* kkp = a->in[I_KK] + l * 512;
    const float* kap = a->in[I_KA] + l * 512; const float* rkp = a->in[I_RK] + l * 512; const float* vr0 = a->in[I_VRES0] + (l > 0 ? l - 1 : 0) * 512;
    float c_mr[8], c_mk[8], c_mv[8], c_w0[8], c_a0[8], c_kk[8], c_ka[8], c_rk[8], c_v0[8];
#pragma unroll
    for (int h = 0; h < 8; ++h) { const int c = h * 64 + lane; c_mr[h] = mu[c]; c_mk[h] = mu[512 + c]; c_mv[h] = mu[1024 + c]; c_w0[h] = w0[c]; c_a0[h] = a0[c]; c_kk[h] = kkp[c]; c_ka[h] = kap[c]; c_rk[h] = rkp[c]; c_v0[h] = vr0[c]; }
    for (int row = gw; row < T; row += ngw) {
        const int t = row % LT;
        bf16_t u_r[8], u_k[8], u_v[8], u_rp[8], u_kp[8], u_vp[8], u_w[8], u_a[8], u_g[8], u_f[8];
        const size_t prow = t > 0 ? (size_t)row - 1 : (size_t)row; const float pm = t > 0 ? 1.f : 0.f;
#pragma unroll
        for (int h = 0; h < 8; ++h) { const int c = h * 64 + lane; const bf16_t* cur = RW + (size_t)row * 2048 + c; const bf16_t* prv = RW + prow * 2048 + c; const bf16_t* lo = LO + (size_t)row * 2048 + c;
            u_r[h] = cur[0]; u_k[h] = cur[512]; u_v[h] = cur[1024]; u_rp[h] = prv[0]; u_kp[h] = prv[512]; u_vp[h] = prv[1024]; u_w[h] = lo[0]; u_a[h] = lo[512];
            u_g[h] = lo[1536]; u_f[h] = VFIRST[(size_t)row * 512 + c]; }
        float q_r[8], q_k[8], q_v[8], q_rp[8], q_kp[8], q_vp[8], q_w[8], q_a[8], q_g[8], q_f[8];
#pragma unroll
        for (int h = 0; h < 8; ++h) { q_r[h] = bf2f(u_r[h]); q_k[h] = bf2f(u_k[h]); q_v[h] = bf2f(u_v[h]); q_rp[h] = pm * bf2f(u_rp[h]); q_kp[h] = pm * bf2f(u_kp[h]); q_vp[h] = pm * bf2f(u_vp[h]);
            q_w[h] = bf2f(u_w[h]); q_a[h] = bf2f(u_a[h]); q_g[h] = bf2f(u_g[h]); q_f[h] = bf2f(u_f[h]); }
#pragma unroll
        for (int h = 0; h < 8; ++h) { const int c = h * 64 + lane;
            const float r = q_r[h] + (q_rp[h] - q_r[h]) * c_mr[h], kr = q_k[h] + (q_kp[h] - q_k[h]) * c_mk[h]; float vr = q_v[h] + (q_vp[h] - q_v[h]) * c_mv[h];
            const float wl = -fsoftplus(-(c_w0[h] + q_w[h])) - 0.5f, ew = fexp(wl), av = fsigmoid(c_a0[h] + q_a[h]);
            if (l == 0) VFIRST[(size_t)row * 512 + c] = f2bf(vr); else vr += (q_f[h] - vr) * fsigmoid(c_v0[h] + q_g[h]);
            float kk = kr * c_kk[h]; kk = kk * __builtin_amdgcn_rsqf(fmaxf(wave_sum(kk * kk), 1e-24f));
            const float k2 = kr * (1.f + (av - 1.f) * c_ka[h]); const float bon = wave_sum(r * k2 * c_rk[h]);
            bf16_t* lo = LO + (size_t)row * 2048 + c;
            RFIN[(size_t)row * 512 + c] = f2bf(r); RW[(size_t)row * 2048 + 1536 + c] = f2bf(k2); VMIX[(size_t)row * 512 + c] = f2bf(vr);
            lo[0] = f2bf(-kk); lo[512] = f2bf(kk * av); lo[1536] = f2bf(ew);
            if (lane == 0) BONUS[(size_t)row * 8 + h] = bon; }
    }
}

constexpr int TC = 32;
constexpr int RW_BUF = 14336;
__device__ __forceinline__ float row16_sum(float v) {
    v += dpp0<0xB1, 0xF>(v); v += dpp0<0x4E, 0xF>(v); v += dpp0<0x141, 0xF>(v); v += dpp0<0x140, 0xF>(v); return v;
}
#define RW_BAR() do { asm volatile("s_waitcnt lgkmcnt(0)" ::: "memory"); __builtin_amdgcn_s_barrier(); asm volatile("" ::: "memory"); } while (0)
__device__ __forceinline__ void rwkv_phase(CArgs a, int l, LAS unsigned char* lds, int wave, int lane) {
    const bf16_t* RW = (const bf16_t*)(a->ws + OFF_E); const bf16_t* LO = (const bf16_t*)(a->ws + OFF_F);
    bf16_t* VFIRST = (bf16_t*)(a->ws + OFF_VFIRST); bf16_t* VMIX = (bf16_t*)(a->ws + OFF_HH);
    float* Y = (float*)(a->ws + OFF_G); float* BONUS = (float*)(a->ws + OFF_BONUS);
    LAS float* L0 = (LAS float*)lds;
    constexpr int NCH = (LT + TC - 1) / TC;
    for (int u = blockIdx.x; u < 256; u += gridDim.x) {
        const int bh = (u & 7) * 4 + (u >> 6), rg = (u >> 3) & 7, b = bh >> 3, h = bh & 7;
        if (wave >= 4) {
            const int c = h * 64 + lane, pw = wave - 4;
            const bf16_t* RFIN = (const bf16_t*)(a->ws + OFF_I);
            unsigned x_r[4], x_w[4], x_k[4], x_n[4], x_b[4], x_v[4], y_r[4], y_w[4], y_k[4], y_n[4], y_b[4], y_v[4];
            const int ts = lane >> 5, c2 = h * 64 + 2 * (lane & 31);
            typedef float f32x2p __attribute__((ext_vector_type(2)));
#define RW_LOAD(S, t0_) do { _Pragma("unroll") for (int g = 0; g < 4; ++g) { int t = (t0_) + pw + 4 * (2 * g + ts); t = t < LT ? t : LT - 1;     \
                const size_t row = (size_t)b * LT + t; const bf16_t* lo = LO + row * 2048 + c2; \
                { const int to_ = (t0_) + pw + 4 * (2 * g + ts); const int tr_ = (to_ < LT ? to_ : LT) - 1; const size_t rowr = (size_t)b * LT + (tr_ > 0 ? tr_ : 0); S##_r[g] = *(const unsigned*)(RFIN + rowr * 512 + c2); }     \
                S##_w[g] = *(const unsigned*)(lo + 1536); S##_k[g] = *(const unsigned*)(RW + row * 2048 + 1536 + c2); \
                S##_n[g] = *(const unsigned*)lo; S##_b[g] = *(const unsigned*)(lo + 512); S##_v[g] = *(const unsigned*)(VMIX + row * 512 + c2); } } while (0)
#define RW_FINAL(S, t0_, buf_) do { LAS float* B_ = L0 + (buf_) * RW_BUF; _Pragma("unroll") for (int g = 0; g < 4; ++g) { const int tt = pw + 4 * (2 * g + ts); \
                *(LAS f32x4*)(B_ + tt * 128 + 4 * (lane & 31)) = (f32x4){fexp(-bflo(S##_w[g])), fexp(-bfhi(S##_w[g])), bflo(S##_k[g]), bfhi(S##_k[g])}; \
                *(LAS f32x4*)(B_ + 4096 + tt * 128 + 4 * (lane & 31)) = (f32x4){bflo(S##_n[g]), bflo(S##_r[g]), bfhi(S##_n[g]), bfhi(S##_r[g])};     \
                *(LAS f32x2p*)(B_ + 8192 + tt * 128 + 2 * (lane & 31)) = (f32x2p){bflo(S##_b[g]), bfhi(S##_b[g])}; \
                *(LAS f32x2p*)(B_ + 12288 + tt * 64 + 2 * (lane & 31)) = (f32x2p){bflo(S##_v[g]), bfhi(S##_v[g])}; } } while (0)
            RW_LOAD(x, 0); RW_LOAD(y, TC); RW_FINAL(x, 0, 0);
            RW_BAR();
            for (int ci = 0; ci < NCH; ++ci) {
                const int t0 = ci * TC;
                if (ci & 1) { if (ci + 2 < NCH) RW_LOAD(y, t0 + 2 * TC); if (ci + 1 < NCH) RW_FINAL(x, t0 + TC, 0); }
                else        { if (ci + 2 < NCH) RW_LOAD(x, t0 + 2 * TC); if (ci + 1 < NCH) RW_FINAL(y, t0 + TC, 1); }
                RW_BAR();
            }
#undef RW_LOAD
#undef RW_FINAL
        } else {
            const int q = lane & 31, rho = rg * 8 + wave * 2 + (lane >> 5);
            typedef float f32x2v __attribute__((ext_vector_type(2)));
            f32x2v s = (f32x2v){0.f, 0.f};
            RW_BAR();
            for (int ci = 0; ci < NCH; ++ci) {
                const int t0 = ci * TC, n = (LT - t0) < TC ? (LT - t0) : TC;
                const LAS float* B_ = L0 + (ci & 1) * RW_BUF;
                float yb = 0.f, yb1 = 0.f, ylast = 0.f; const int q16 = lane & 15; const bool yrow = (lane & 16) != 0;
#define RW_ISSUE_A(tt_, R2_, WK_, NB_, V2_) do { \
                    asm volatile("ds_read_b128 %0, %1 offset:%2" : "=v"(NB_) : "v"(abase), "i"(16384 + (tt_) * 512)); asm volatile("ds_read_b128 %0, %1 offset:%2" : "=v"(WK_) : "v"(abase), "i"((tt_) * 512)); \
                    asm volatile("ds_read2st64_b32 %0, %1 offset0:%2 offset1:%3" : "=v"(V2_) : "v"(vbase), "i"(192 + (tt_)), "i"(193 + (tt_))); \
                    asm volatile("ds_read2st64_b64 %0, %1 offset0:%2 offset1:%3" : "=v"(R2_) : "v"(rbase), "i"(64 + (tt_)), "i"(65 + (tt_))); } while (0)
#define RW_ISSUE_B(tt_, WK_, NB_) do { \
                    asm volatile("ds_read_b128 %0, %1 offset:%2" : "=v"(NB_) : "v"(abase), "i"(16384 + (tt_) * 512)); asm volatile("ds_read_b128 %0, %1 offset:%2" : "=v"(WK_) : "v"(abase), "i"((tt_) * 512)); } while (0)
#define RW_WAIT_A(NN_, R2_, WK_, NB_, V2_) asm volatile("s_waitcnt lgkmcnt(" #NN_ ")" : "+v"(R2_), "+v"(WK_), "+v"(NB_), "+v"(V2_))
#define RW_WAIT_B(NN_, WK_, NB_) asm volatile("s_waitcnt lgkmcnt(" #NN_ ")" : "+v"(WK_), "+v"(NB_))
#define RW_SUM32_2(x_, y_) do { x_ += dpp0<0xB1, 0xF>(x_); y_ += dpp0<0xB1, 0xF>(y_); x_ += dpp0<0x4E, 0xF>(x_); y_ += dpp0<0x4E, 0xF>(y_); \
                    x_ += dpp0<0x141, 0xF>(x_); y_ += dpp0<0x141, 0xF>(y_); x_ += dpp0<0x140, 0xF>(x_); y_ += dpp0<0x140, 0xF>(y_); \
                      \
                    const auto sw_ = __builtin_amdgcn_permlane16_swap(__float_as_uint(x_), __float_as_uint(y_), false, false); \
                    const float cb_ = __uint_as_float(sw_[0]) + __uint_as_float(sw_[1]); y_ = cb_; \
                    x_ = __builtin_bit_cast(float, __builtin_amdgcn_update_dpp(__builtin_bit_cast(int, cb_), __builtin_bit_cast(int, cb_), 0x142, 0xA, 0xF, false)); } while (0)
#define RW_STEP(tt_, Bv_, WK_, NR_, V_) do { const f32x2v W_ = (f32x2v){WK_.x, WK_.y}, K_ = (f32x2v){WK_.z, WK_.w}; \
                    const f32x2v tw_ = s * W_ + V_ * K_;     \
                    f32x2v p_ = (f32x2v){s.x, s.x} * (f32x2v){NR_.x, NR_.y}; p_ = (f32x2v){s.y, s.y} * (f32x2v){NR_.z, NR_.w} + p_;     \
                    float sa = p_.x, yv = p_.y; RW_SUM32_2(sa, yv); \
                    if ((tt_) == 0) ylast = yv; else if (q16 == (((tt_) - 1) & 15)) { if ((tt_) - 1 < 16) yb = yv; else yb1 = yv; } s = tw_ + sa * Bv_; } while (0)
                static_assert(TC == 32, "asm offsets assume TC = 32");
                const unsigned abase = (unsigned)(size_t)B_ + 16u * (unsigned)q, rbase = (unsigned)(size_t)B_ + 8u * (unsigned)q, vbase = (unsigned)(size_t)B_ + 4u * (unsigned)rho;
                f32x4 r2, wkA, nbA, wkB, nbB; f32x2v v2;
#define RW_PAIR(tt_) do { RW_ISSUE_B((tt_) + 1, wkB, nbB); RW_WAIT_A(2, r2, wkA, nbA, v2); \
                    const f32x2v rA_ = (f32x2v){r2.x, r2.y}, rB_ = (f32x2v){r2.z, r2.w}; const float vA_ = v2.x, vB_ = v2.y; RW_STEP((tt_), rA_, wkA, nbA, vA_); \
                    RW_ISSUE_A(((tt_) + 2 < TC ? (tt_) + 2 : (tt_)), r2, wkA, nbA, v2); RW_WAIT_B(4, wkB, nbB); RW_STEP((tt_) + 1, rB_, wkB, nbB, vB_); } while (0)
                RW_ISSUE_A(0, r2, wkA, nbA, v2);
                RW_PAIR(0); RW_PAIR(2); RW_PAIR(4); RW_PAIR(6); RW_PAIR(8); RW_PAIR(10); RW_PAIR(12); RW_PAIR(14);
                if (n > 16) { RW_PAIR(16); RW_PAIR(18); RW_PAIR(20); RW_PAIR(22); RW_PAIR(24); RW_PAIR(26); RW_PAIR(28); RW_PAIR(30); }
#undef RW_PAIR
                RW_WAIT_A(0, r2, wkA, nbA, v2);
#undef RW_ISSUE_A
#undef RW_ISSUE_B
#undef RW_WAIT_A
#undef RW_WAIT_B
#undef RW_STEP
                if (yrow) {
                    if (q16 < n - 1) Y[((size_t)b * LT + t0 + q16) * 512 + h * 64 + rho] = yb;
                    if (q16 + 16 < n - 1) Y[((size_t)b * LT + t0 + q16 + 16) * 512 + h * 64 + rho] = yb1;
                    if (ci > 0 && q16 == 0) Y[((size_t)b * LT + t0 - 1) * 512 + h * 64 + rho] = ylast;
                }
                RW_BAR();
            }
            { const LAS float* Bl_ = L0 + ((NCH - 1) & 1) * RW_BUF + 4096 + (LT - (NCH - 1) * TC) * 128 + 4 * q; float yv = s.x * Bl_[1] + s.y * Bl_[3], dummy = 0.f; RW_SUM32_2(yv, dummy);
              if (q == 0) Y[((size_t)b * LT + LT - 1) * 512 + h * 64 + rho] = yv; }
#undef RW_SUM32_2
        }
    }
}

__device__ __forceinline__ void rw_post(CArgs a, int l, int lane, int gw, int ngw) {
    const float* Y = (const float*)(a->ws + OFF_G); const bf16_t* LO = (const bf16_t*)(a->ws + OFF_F); const bf16_t* VMIX = (const bf16_t*)(a->ws + OFF_HH);
    const float* BONUS = (const float*)(a->ws + OFF_BONUS); bf16_t* YRW = (bf16_t*)(a->ws + OFF_I);
    float lw[NH], lb[NH];
#pragma unroll
    for (int h = 0; h < NH; ++h) { lw[h] = a->in[I_LNW][l * 512 + h * 64 + lane]; lb[h] = a->in[I_LNB][l * 512 + h * 64 + lane]; }
    float yv[NH], bo[NH]; bf16_t vm[NH], gg[NH];
#define RP_LOAD(r_, YV, BO, VM, GG) do { const int rr_ = (r_) < T ? (r_) : T - 1; _Pragma("unroll") for (int h = 0; h < NH; ++h) { const int c = h * 64 + lane; \
        YV[h] = Y[(size_t)rr_ * 512 + c]; BO[h] = BONUS[(size_t)rr_ * 8 + h]; VM[h] = VMIX[(size_t)rr_ * 512 + c]; GG[h] = LO[(size_t)rr_ * 2048 + 1024 + c]; } } while (0)
    RP_LOAD(gw, yv, bo, vm, gg);
    for (int row = gw; row < T; row += ngw) {
        float yn_[NH], bn_[NH]; bf16_t vn_[NH], gn_[NH];
        RP_LOAD(row + ngw, yn_, bn_, vn_, gn_);
#pragma unroll
        for (int h = 0; h < NH; ++h) {
            const int c = h * 64 + lane;
            const float y = yv[h];
            const float mean = wave_sum(y) * (1.f / 64.f), d = y - mean;
            const float var = wave_sum(d * d) * (1.f / 64.f);
            const float yn = d * rsqrtf(var + GN_EPS) * lw[h] + lb[h];
            const float o = (yn + bo[h] * bf2f(vm[h])) * bf2f(gg[h]);
            YRW[(size_t)row * 512 + c] = f2bf(o);
        }
#pragma unroll
        for (int h = 0; h < NH; ++h) { yv[h] = yn_[h]; bo[h] = bn_[h]; vm[h] = vn_[h]; gg[h] = gn_[h]; }
    }
#undef RP_LOAD
}

__device__ __forceinline__ void final_out(CArgs a, int lane, int gw, int ngw) {
    const bf16_t* HB = (const bf16_t*)(a->ws + OFF_HB); const float* ssq = (const float*)(a->ws + OFF_SSQ);
    f32x4 g[4];
#pragma unroll
    for (int j = 0; j < 4; ++j) g[j] = *((const f32x4*)a->in[I_NFIN] + lane + 64 * j);
    for (int o0 = gw; o0 < NB * SEQ; o0 += 4 * ngw) {
        u32x2 hv[4][4]; float rs[4];
#pragma unroll
        for (int k = 0; k < 4; ++k) { const int o = o0 + k * ngw < NB * SEQ ? o0 + k * ngw : NB * SEQ - 1; const int b = o / SEQ, s = o - b * SEQ, row = b * LT + NMETA + s;
            rs[k] = row_rstd(ssq, row);
#pragma unroll
            for (int j = 0; j < 4; ++j) hv[k][j] = *((const u32x2*)(HB + (size_t)row * DM) + lane + 64 * j); }
#pragma unroll
        for (int k = 0; k < 4; ++k) { const int o = o0 + k * ngw;
            if (o < NB * SEQ) {
#pragma unroll
                for (int j = 0; j < 4; ++j) { const f32x4 v = (f32x4){bflo(hv[k][j].x), bfhi(hv[k][j].x), bflo(hv[k][j].y), bfhi(hv[k][j].y)}; *((f32x4*)(a->out + (size_t)o * DM) + lane + 64 * j) = v * rs[k] * g[j]; }
            } }
    }
}

#define RLX_AGENT __ATOMIC_RELAXED, __HIP_MEMORY_SCOPE_AGENT
#define XB_TMO      128
#define XB_XCNT(j)  (256  + 64 * (j))
#define XB_XSUB(j)  (1280 + 64 * (j))
#define XB_XGEN(j)  (2304 + 64 * (j))
#define XB_TOP      3328
#define XB_TOPGEN   3392
#define XCD_BAR_WORDS 3456
#define XB_SPIN_CAP (1u << 18)

__device__ __forceinline__ unsigned xb_ld(unsigned* p)              { return __hip_atomic_load(p, __ATOMIC_RELAXED, __HIP_MEMORY_SCOPE_AGENT); }
__device__ __forceinline__ unsigned xb_add(unsigned* p, unsigned v) { return __hip_atomic_fetch_add(p, v, __ATOMIC_RELAXED, __HIP_MEMORY_SCOPE_AGENT); }
__device__ __forceinline__ unsigned xb_xcc_id() { return (unsigned)__builtin_amdgcn_s_getreg((3 << 11) | 20) & 0xFu; }
#define XB_SPIN(cond, bar) do { unsigned _sp = 0; while (cond) { __builtin_amdgcn_s_sleep(1); \
    if ((++_sp & 255u) == 0u) { if (xb_ld(&(bar)[XB_TMO])) break; if (_sp > XB_SPIN_CAP) { atomicAdd(&(bar)[XB_TMO], 1u); break; } } } } while (0)

struct XcdBarrier {
    unsigned* bar; unsigned x;
    volatile LAS unsigned* st;
};

__device__ __forceinline__ XcdBarrier xcd_barrier_post(unsigned* bar, volatile LAS unsigned* st) {
    XcdBarrier b; b.bar = bar; b.x = xb_xcc_id(); b.st = st;
    if (threadIdx.x == 0) (void)xb_add(&bar[XB_XCNT(b.x)], 1u);
    return b;
}
__device__ __forceinline__ void xcd_barrier_complete(unsigned* bar, unsigned x, unsigned& nloc, unsigned& nx) {
    const unsigned G = gridDim.x * gridDim.y * gridDim.z;
    unsigned sum, cnt, mine, sp = 0u;
    for (;;) {
        sum = 0u; cnt = 0u; mine = 0u;
#pragma unroll
        for (unsigned j = 0; j < 16; ++j) { const unsigned c = xb_ld(&bar[XB_XCNT(j)]); sum += c; cnt += (c > 0u) ? 1u : 0u; mine = (j == x) ? c : mine; }
        if (sum == G) break;
        __builtin_amdgcn_s_sleep(1);
        if ((++sp & 255u) == 0u) { if (xb_ld(&bar[XB_TMO])) break; if (sp > XB_SPIN_CAP) { atomicAdd(&bar[XB_TMO], 1u); break; } }
    }
    nloc = mine > 0u ? mine : 1u; nx = cnt > 0u ? cnt : 1u;
}

__device__ __forceinline__ void xcd_barrier(const XcdBarrier& b) {
    asm volatile("s_waitcnt vmcnt(0)" ::: "memory");
    __syncthreads();
    if (threadIdx.x == 0) {
        unsigned* bar = b.bar;
        __builtin_amdgcn_s_waitcnt(0);
        unsigned nloc = b.st[0], nx = b.st[1];
        if (nloc == 0u) { xcd_barrier_complete(bar, b.x, nloc, nx); b.st[0] = nloc; b.st[1] = nx; }
        const unsigned old = xb_add(&bar[XB_XSUB(b.x)], 1u);
        const unsigned gen = old / nloc;
        if (old + 1u == (gen + 1u) * nloc) {
            __builtin_amdgcn_fence(__ATOMIC_RELEASE, "agent");
            asm volatile("s_waitcnt vmcnt(0)" ::: "memory");
            const unsigned og = xb_add(&bar[XB_TOP], 1u);
            const unsigned tg = og / nx;
            if (og + 1u == (tg + 1u) * nx) xb_add(&bar[XB_TOPGEN], 1u);
            else XB_SPIN(xb_ld(&bar[XB_TOPGEN]) == tg, bar);
            __builtin_amdgcn_fence(__ATOMIC_ACQUIRE, "agent");
            xb_add(&bar[XB_XGEN(b.x)], 1u);
            asm volatile("s_waitcnt vmcnt(0)" ::: "memory");
        } else {
            XB_SPIN(xb_ld(&bar[XB_XGEN(b.x)]) == gen, bar);
            __builtin_amdgcn_fence(__ATOMIC_ACQUIRE, "agent");
            asm volatile("s_waitcnt vmcnt(0)" ::: "memory");
        }
    }
    __syncthreads();
}


#if PROBE_SYNC2
#define PROBE_EXTRA_SYNC asm volatile("s_waitcnt vmcnt(0)" ::: "memory"); grid.sync(); if (threadIdx.x == 0) { __builtin_amdgcn_fence(__ATOMIC_ACQUIRE, "agent"); asm volatile("s_waitcnt vmcnt(0)" ::: "memory"); } __syncthreads();
#else
#define PROBE_EXTRA_SYNC
#endif
#define GSYNC() do { asm volatile("s_waitcnt vmcnt(0)" ::: "memory"); grid.sync(); \
    if (threadIdx.x == 0) { __builtin_amdgcn_fence(__ATOMIC_ACQUIRE, "agent"); asm volatile("s_waitcnt vmcnt(0)" ::: "memory"); } \
    __syncthreads(); PROBE_EXTRA_SYNC } while (0)
#define XSYNC() xcd_barrier(xbar)
#ifndef AL1
#define AL1 false
#endif
#ifndef AL2
#define AL2 true
#endif
#ifndef AL3
#define AL3 true
#endif
#ifndef AL4
#define AL4 false
#endif
#ifndef AL5
#define AL5 true
#endif
#ifndef AL6
#define AL6 true
#endif
#ifndef AL7
#define AL7 true
#endif
#ifndef AL8
#define AL8 true
#endif
#ifndef AL9
#define AL9 true
#endif
#define COMMA ,
#ifndef GALIGN
#define GALIGN false
#endif
#ifndef GSP2
#define GSP2 true
#endif
#define GEMM_CALLX(EpiT, AL, gA, gB, gM, gN, gK, E) for (int rep_ = 0; rep_ < ((#AL)[2] == '7' || (#AL)[2] == '9' || (#AL)[2] == '6' ? 1 : 1 + PROBE_GEMM2); ++rep_) do { pg8::Gemm g_{(const bf16_t*)(gA), (const bf16_t*)(gB), (gM), (gN), (gK)}; pg8::StaticOrder S_; S_.init((gM), (gN), (int)gridDim.x, (int)blockIdx.x); \
    pg8::gemm_phase<EpiT, pg8::StaticOrder, AL, GSP2>(lds, g_, S_, (E)); } while (0)

__global__ void __launch_bounds__(NTHREADS, 2) fwd_megakernel(Args a_unused) {
    const CArgs ap = (CArgs)__builtin_amdgcn_kernarg_segment_ptr();
#define a opq_args(ap)
    extern __shared__ __attribute__((aligned(16))) unsigned char lds_raw[];
    LAS unsigned char* lds = (LAS unsigned char*)lds_raw;
    cg::grid_group grid = cg::this_grid();
    volatile LAS unsigned* bst = (volatile LAS unsigned*)(lds + 140032);
    if (threadIdx.x < 2) bst[threadIdx.x] = 0u;
    __syncthreads();
    const XcdBarrier xbar = xcd_barrier_post((unsigned*)(((CArgs)__builtin_amdgcn_kernarg_segment_ptr())->ws + OFF_BAR), bst);
    const int tid = threadIdx.x, lane = tid & 63, wave = __builtin_amdgcn_readfirstlane(tid >> 6);
    const int gw = blockIdx.x * NWAVES + wave, ngw = gridDim.x * NWAVES;
#define ws (opq_args(ap)->ws)
#define ssq ((float*)(ws + OFF_SSQ))

#if !defined(NO_P0)
    init_rows(a, lane, gw, ngw);
    convert_mix_weights(a, 0, lds, wave, lane, gw, ngw);
#endif
    GSYNC();

    for (int l = 0; l < DEPTH; ++l) {
#ifndef NO_PH1
        { EpiStore<0, true> E{(bf16_t*)(ws + OFF_G), 1024, (bf16_t*)(ws + OFF_E), 2048, 4, ssq, C2, 2};
          GEMM_CALLX(EpiStore<0 COMMA true>, AL2, ws + OFF_HB, ws + OFF_W1A, MB, 3072, 1024, E);
          TStore<0, true> TE{{(bf16_t*)(ws + OFF_G), 1024, (bf16_t*)(ws + OFF_E), 2048, 1024, ssq, C2, 512}};
          tail_gemm(lds, (const bf16_t*)(ws + OFF_HB) + (size_t)MB * 1024, (const bf16_t*)(ws + OFF_W1A), 1024, 3072, TE, wave, opq(lane), 128); }
        { EpiVT E{(bf16_t*)(ws + OFF_HH), MP, ssq};
          GEMM_CALLX(EpiVT, AL3, ws + OFF_WV, ws + OFF_HB, 512, MB, 1024, E);
          TVT TE{(bf16_t*)(ws + OFF_HH), MP, ssq};
          tail_gemm(lds, (const bf16_t*)(ws + OFF_HB) + (size_t)MB * 1024, (const bf16_t*)(ws + OFF_WV), 1024, 512, TE, wave, opq(lane), 176);
          { const int cb = gridDim.x >= 256 ? 128 : 0; if ((int)blockIdx.x >= cb) convert_ffn_weights(a, l, lds, wave, opq(lane), ((int)blockIdx.x - cb) * NWAVES + wave, ((int)gridDim.x - cb) * NWAVES); } }
#endif
        XSYNC();
#ifndef NO_PH2
        if (ngw == 2048) {
            if (gw < 32) { for (int k = 0; k < 3; ++k) sb_unit((const bf16_t*)(ws + OFF_G), (const bf16_t*)(ws + OFF_HH), (bf16_t*)(ws + OFF_J), gw >> 3, gw & 7, k < 2 ? k : 128, opq(lane)); }
            else { for (int k = 0; k < 2; ++k) { const int i = (gw - 32) + k * 2016, bh = i / 126, qb = 2 + (i - bh * 126); sb_unit((const bf16_t*)(ws + OFF_G), (const bf16_t*)(ws + OFF_HH), (bf16_t*)(ws + OFF_J), bh >> 3, bh & 7, qb, opq(lane)); } }
        } else
        for (int u = gw; u < NB * NH * 129; u += ngw) { const int bh = u / 129, qb = u - bh * 129; sb_unit((const bf16_t*)(ws + OFF_G), (const bf16_t*)(ws + OFF_HH), (bf16_t*)(ws + OFF_J), bh >> 3, bh & 7, qb, opq(lane)); }
        for (int rep_ = 0; rep_ < 1 + PROBE_MISC2; ++rep_) lora_act(a, l, opq(lane), gw, ngw);
#endif
        XSYNC();
#ifndef NO_PH3
        { EpiStore<0, false> E{(bf16_t*)(ws + OFF_F), 2048, (bf16_t*)(ws + OFF_F), 2048, 1 << 20, nullptr, 1.f, 0};
          GEMM_CALLX(EpiStore<0 COMMA false>, AL4, ws + OFF_I, ws + OFF_WL, MB, 2048, 384, E);
          TStore<0, false> TE{{(bf16_t*)(ws + OFF_F), 2048, (bf16_t*)(ws + OFF_F), 2048, 1 << 30, nullptr, 1.f, 0}};
          tail_gemm(lds, (const bf16_t*)(ws + OFF_I) + (size_t)MB * 384, (const bf16_t*)(ws + OFF_WL), 384, 2048, TE, wave, opq(lane)); }
#endif
        XSYNC();
        rw_finalise(a, l, opq(lane), gw, ngw);
        XSYNC();
#ifndef NO_PH4
        rwkv_phase(a, l, lds, wave, opq(lane));
#if PROBE_RW2
        rwkv_phase(a, l, lds, wave, opq(lane));
#endif
#endif
        XSYNC();
#ifndef NO_PH5
        for (int rep_ = 0; rep_ < 1 + PROBE_MISC2; ++rep_) rw_post(a, l, opq(lane), gw, ngw);
        { EpiStore<1, true> E{(bf16_t*)(ws + OFF_E), 2048, (bf16_t*)(ws + OFF_E), 2048, 1 << 20, ssq, 1.f, 0};
          GEMM_CALLX(EpiStore<1 COMMA true>, AL5, ws + OFF_HB, ws + OFF_WG, MB, 2048, 1024, E);
          TStore<1, true> TE{{(bf16_t*)(ws + OFF_E), 2048, (bf16_t*)(ws + OFF_E), 2048, 1 << 30, ssq, 1.f, 0}};
          tail_gemm(lds, (const bf16_t*)(ws + OFF_HB) + (size_t)MB * 1024, (const bf16_t*)(ws + OFF_WG), 1024, 2048, TE, wave, opq(lane)); }
#endif
        XSYNC();
#ifndef NO_PH6
        for (int br = 0; br < 2; ++br) {
            EpiGateMul E{(bf16_t*)(ws + OFF_F), (const bf16_t*)(ws + OFF_E), 2048, br * 1024, br};
            GEMM_CALLX(EpiGateMul, AL6, br ? ws + OFF_I : ws + OFF_J, br ? ws + OFF_WRW : ws + OFF_WSB, MB, 1024, 512, E);
            TGateMul TE{(bf16_t*)(ws + OFF_F), (const bf16_t*)(ws + OFF_E), 2048, br * 1024, br};
            tail_gemm(lds, (const bf16_t*)(br ? ws + OFF_I : ws + OFF_J) + (size_t)MB * 512, (const bf16_t*)(br ? ws + OFF_WRW : ws + OFF_WSB), 512, 1024, TE, wave, opq(lane));
        }
#endif
        XSYNC();
#ifndef NO_PH7
        { EpiResid E{(bf16_t*)(ws + OFF_HB), ssq + (size_t)MP * 16};
          GEMM_CALLX(EpiResid, AL7, ws + OFF_F, ws + OFF_WO, MB, 1024, 1024, E);
          TResid TE{(bf16_t*)(ws + OFF_HB), ssq + (size_t)MP * 16};
          tail_gemm(lds, (const bf16_t*)(ws + OFF_F) + (size_t)MB * 1024, (const bf16_t*)(ws + OFF_WO), 1024, 1024, TE, wave, opq(lane)); }
#endif
        XSYNC();
#ifndef NO_PH8
        { EpiSwiglu E{(bf16_t*)(ws + OFF_E), ssq + (size_t)MP * 16};
          GEMM_CALLX(EpiSwiglu, AL8, ws + OFF_HB, ws + OFF_WF1, MB, 2 * FFH, 1024, E);
          TSwiglu TE{(bf16_t*)(ws + OFF_E), ssq + (size_t)MP * 16};
          tail_gemm(lds, (const bf16_t*)(ws + OFF_HB) + (size_t)MB * 1024, (const bf16_t*)(ws + OFF_WF1), 1024, 2 * FFH, TE, wave, opq(lane), 128);
          { const int cb = gridDim.x >= 256 ? 128 : 0; if (l + 1 < DEPTH && (int)blockIdx.x >= cb) convert_mix_weights(a, l + 1, lds, wave, opq(lane), ((int)blockIdx.x - cb) * NWAVES + wave, ((int)gridDim.x - cb) * NWAVES); } }
#endif
        XSYNC();
#ifndef NO_PH9
        { EpiResid E{(bf16_t*)(ws + OFF_HB), ssq};
          GEMM_CALLX(EpiResid, AL9, ws + OFF_E, ws + OFF_WF2, MB, 1024, FFH, E);
          TResid TE{(bf16_t*)(ws + OFF_HB), ssq};
          tail_gemm(lds, (const bf16_t*)(ws + OFF_E) + (size_t)MB * FFH, (const bf16_t*)(ws + OFF_WF2), FFH, 1024, TE, wave, opq(lane)); }
#endif
        XSYNC();
    }
    final_out(a, opq(lane), gw, ngw);
#undef a
#undef ws
#undef ssq
}

extern "C" void kernel_launch(void* const* d_in, const int* in_sizes, int n_in, void* d_out, int out_size, void* d_ws, size_t ws_size, hipStream_t stream) {
    static int grid = 0;
    if (grid == 0) {
        if (n_in != 26 || out_size != NB * SEQ * DM || ws_size < WS_END) { fprintf(stderr, "kernel_launch: unexpected problem (n_in %d, out %d, ws %zu < %zu)\n", n_in, out_size, ws_size, (size_t)WS_END); grid = -1; return; }
        int dev = 0, cus = 0, per_cu = 0;
        hipGetDevice(&dev); hipDeviceGetAttribute(&cus, hipDeviceAttributeMultiprocessorCount, dev);
        if (hipFuncSetAttribute((const void*)fwd_megakernel, hipFuncAttributeMaxDynamicSharedMemorySize, LDS_BYTES) != hipSuccess) { fprintf(stderr, "kernel_launch: hipFuncSetAttribute failed\n"); grid = -1; return; }
        if (hipOccupancyMaxActiveBlocksPerMultiprocessor(&per_cu, (const void*)fwd_megakernel, NTHREADS, LDS_BYTES) != hipSuccess || per_cu < 1) per_cu = 1;
        (void)hipGetLastError();
        grid = cus * per_cu;
    }
    if (grid < 0) return;
    if (hipMemsetAsync((char*)d_ws + OFF_BAR, 0, 16384, stream) != hipSuccess) { fprintf(stderr, "kernel_launch: hipMemsetAsync failed\n"); return; }
    Args a{};
    for (int i = 0; i < 26; ++i) a.in[i] = (const float*)d_in[i];
    a.out = (float*)d_out; a.ws = (unsigned char*)d_ws;
    void* args[] = {&a};
    hipError_t e = hipLaunchCooperativeKernel((const void*)fwd_megakernel, dim3(grid), dim3(NTHREADS), args, LDS_BYTES, stream);
    if (e != hipSuccess) fprintf(stderr, "cooperative launch failed: %s (grid %d)\n", hipGetErrorString(e), grid);
}
```
